# Optimizing an MI355X kernel written in HIP

```python
import math
import jax
import jax.numpy as jnp
from jax import lax
import numpy as np

D_MODEL = 2048
BATCH = 4
SEQ = 2048
DEPTH = 4
DEC_BATCH = 128
DEC_SEQ = 8
PAST_LEN = 16384
PAGE_SIZE = 128

N_EVEN = (DEPTH + 1) // 2
N_ODD = DEPTH // 2

D_A = D_MODEL // 2
HGRN_EXPAND = 128
H_A = D_A // HGRN_EXPAND
DK_A = HGRN_EXPAND
DV_A = D_A // H_A
D_B = D_MODEL // 2
N_B = 64
H_B = D_B // N_B
R_W = 64
R_A = 64
R_G = 128
D_RWKV_PROJ = 3 * D_B + R_W + R_A + R_G
D_IN_EVEN = 4 * D_A + D_RWKV_PROJ
D_C = D_MODEL // 2
H_C = 4
DK_C = D_C // H_C
DV_C = D_C // H_C
D_D = D_MODEL // 2
H_D = 4
BW_D = D_D // H_D
CONV_W = 4
LRU_C = 8.0
D_IN_ODD = 4 * D_C + 2 * D_D
D_FF = ((8 * D_MODEL + 3 * 256 - 1) // (3 * 256)) * 256

CHUNK = 64
RMS_EPS = 1e-6
GN_EPS = 64e-5
TINY = 1e-30

kernel_name = 'hgrn2_rwkv7_retnet_rglru_hybrid_step'


def rms_norm(x, w, eps=RMS_EPS):
    xf = x.astype(jnp.float32)
    y = xf * lax.rsqrt(jnp.mean(xf * xf, axis=-1, keepdims=True) + eps)
    return (y * w.astype(jnp.float32)).astype(x.dtype)


def split_cols(z, widths):
    idx = np.cumsum(widths)[:-1].tolist()
    return jnp.split(z, idx, axis=-1)


def to_heads(z, nh):
    b, t, _ = z.shape
    return z.reshape(b, t, nh, -1).transpose(0, 2, 1, 3)


def from_heads(o):
    b, h, t, d = o.shape
    return o.transpose(0, 2, 1, 3).reshape(b, t, h * d)


def head_rms(o):
    return o * lax.rsqrt(jnp.mean(o * o, axis=-1, keepdims=True) + RMS_EPS)


def chunked_gated_linear(q, k, v, log_decay, s0):
    bsz, nh, T, _ = q.shape
    dv = v.shape[-1]
    c = math.gcd(T, CHUNK)
    nc = T // c
    f32 = jnp.float32

    def blocks(a):
        a = a.astype(f32).reshape(bsz, nh, nc, c, a.shape[-1])
        return jnp.moveaxis(a, 2, 0)

    causal = jnp.tril(jnp.ones((c, c), dtype=bool))
    scalar_decay = log_decay.shape[-1] == 1

    def step(s, blk):
        qc, kc, vc, gc = blk
        b = jnp.cumsum(gc, axis=2)
        b_last = b[:, :, -1:, :]
        if scalar_decay:
            diff = b[:, :, :, None, 0] - b[:, :, None, :, 0]
            dec = jnp.where(causal, jnp.exp(jnp.where(causal, diff, 0.0)), 0.0)
            att = jnp.einsum('bhtd,bhsd->bhts', qc, kc) * dec
        else:
            diff = b[:, :, :, None, :] - b[:, :, None, :, :]
            cm = causal[:, :, None]
            dec = jnp.where(cm, jnp.exp(jnp.where(cm, diff, 0.0)), 0.0)
            att = jnp.einsum('bhtd,bhsd,bhtsd->bhts', qc, kc, dec)
        o = jnp.einsum('bhts,bhsv->bhtv', att, vc) + jnp.einsum('bhtd,bhdv->bhtv', qc * jnp.exp(b), s)
        s = jnp.exp(b_last[:, :, 0, :, None]) * s + jnp.einsum('bhsd,bhsv->bhdv', kc * jnp.exp(b_last - b), vc)
        return s, o

    s_fin, o = lax.scan(step, s0.astype(f32), (blocks(q), blocks(k), blocks(v), blocks(log_decay)))
    o = jnp.moveaxis(o, 0, 2).reshape(bsz, nh, T, dv)
    return o, s_fin


def rwkv7_scan(r, w, k, v, kk, a, s0):
    xs = tuple(jnp.moveaxis(t, 1, 0) for t in (r, w, k, v, kk, a))

    def step(s, inp):
        r_t, w_t, k_t, v_t, kk_t, a_t = inp
        sa = jnp.einsum('bhij,bhj->bhi', s, -kk_t)
        s = (s * w_t[:, :, None, :] + sa[..., None] * (kk_t * a_t)[:, :, None, :]
             + v_t[..., None] * k_t[:, :, None, :])
        return s, jnp.einsum('bhij,bhj->bhi', s, r_t)

    s_fin, ys = lax.scan(step, s0.astype(jnp.float32), xs)
    return jnp.moveaxis(ys, 0, 1), s_fin


def linear_scan(a, b, h0):
    b = b.at[:, 0].add(a[:, 0] * h0)

    def combine(l, r):
        a_l, b_l = l
        a_r, b_r = r
        return a_l * a_r, a_r * b_l + b_r

    _, h = lax.associative_scan(combine, (a, b), axis=1)
    return h


def hgrn_lower_bounds(lb_raw):
    pr = jax.nn.softmax(lb_raw.astype(jnp.float32), axis=0)
    return jnp.cumsum(pr, axis=0) - pr[0]


def retention_rotary(pos):
    angle = 1.0 / (10000.0 ** jnp.linspace(0.0, 1.0, DK_C // 2, dtype=jnp.float32))
    angle = jnp.repeat(angle, 2)
    ang = pos.astype(jnp.float32)[:, None] * angle[None, :]
    return jnp.sin(ang), jnp.cos(ang)


def theta_shift(x, sin, cos):
    x1 = x[..., ::2]
    x2 = x[..., 1::2]
    rot = jnp.stack((-x2, x1), axis=-1).reshape(x.shape)
    return x * cos[None, :, None, :] + rot * sin[None, :, None, :]


def swiglu(h, w_in, w_out):
    u = jnp.einsum('btd,df->btf', h, w_in)
    gt, up = jnp.split(u, 2, axis=-1)
    return jnp.einsum('btf,fd->btd', jax.nn.silu(gt) * up, w_out)


def even_mixer(h, lb, s_hgrn, s_rwkv, s_shift, p, j):
    f32 = jnp.float32
    bsz, T, _ = h.shape
    z = jnp.einsum('btd,de->bte', h, p['w_in_even'][j])
    z_a, z_b = z[..., :4 * D_A], z[..., 4 * D_A:]
    q, f_logit, i, g = split_cols(z_a, [D_A] * 4)
    zf = f_logit.astype(f32)
    fg = lb + (1.0 - lb) * jax.nn.sigmoid(zf)
    log_f = jnp.log(jnp.maximum(fg, TINY))
    k_a = (1.0 - lb) * jax.nn.sigmoid(-zf)
    o_a, s_hgrn_new = chunked_gated_linear(to_heads(jax.nn.silu(q), H_A), to_heads(k_a, H_A),
                                           to_heads(i, H_A), to_heads(log_f, H_A), s_hgrn)
    o_a = head_rms(o_a) * p['hgrn_norm_w'][j][:, None, :]
    o_a = from_heads(o_a) * jax.nn.silu(g.astype(f32))
    prev = jnp.concatenate([s_shift[:, None, :].astype(z_b.dtype), z_b[:, :-1]], axis=1)
    zs = z_b + (prev - z_b) * p['rwkv_mu'][j]
    shift_new = z_b[:, -1]
    r, kb, v, wl, al, gl = split_cols(zs, [D_B, D_B, D_B, R_W, R_A, R_G])
    w_log = -jnp.exp(-jax.nn.softplus(-(p['rwkv_w0'][j] + jnp.tanh(wl) @ p['rwkv_w2'][j]).astype(f32)) - 0.5)
    decay = jnp.exp(w_log)
    a = jax.nn.sigmoid((p['rwkv_a0'][j] + al @ p['rwkv_a2'][j]).astype(f32))
    gate = (jax.nn.sigmoid(gl) @ p['rwkv_g2'][j]).astype(f32)
    hs = (bsz, T, H_B, N_B)
    r = r.astype(f32).reshape(hs)
    kb = kb.astype(f32).reshape(hs)
    v = v.astype(f32).reshape(hs)
    a = a.reshape(hs)
    decay = decay.reshape(hs)
    kk = kb * p['rwkv_k_k'][j].reshape(H_B, N_B)
    kk = kk / jnp.maximum(jnp.sqrt(jnp.sum(kk * kk, axis=-1, keepdims=True)), 1e-12)
    kb = kb * (1.0 + (a - 1.0) * p['rwkv_k_a'][j].reshape(H_B, N_B))
    y, s_rwkv_new = rwkv7_scan(r, decay, kb, v, kk, a, s_rwkv)
    mean = jnp.mean(y, axis=-1, keepdims=True)
    var = jnp.mean(jnp.square(y - mean), axis=-1, keepdims=True)
    y = ((y - mean) * lax.rsqrt(var + GN_EPS) * p['rwkv_ln_w'][j].reshape(H_B, N_B)
         + p['rwkv_ln_b'][j].reshape(H_B, N_B))
    y = y + jnp.sum(r * kb * p['rwkv_r_k'][j], axis=-1, keepdims=True) * v
    o_b = y.reshape(bsz, T, D_B) * gate
    o = jnp.concatenate([o_a, o_b], axis=-1).astype(h.dtype)
    out = jnp.einsum('bte,ed->btd', o, p['w_out_even'][j])
    return out, s_hgrn_new, s_rwkv_new, shift_new


def odd_mixer(h, pos, s_ret, s_conv, s_h, p, j):
    f32 = jnp.float32
    bsz, T, _ = h.shape
    z = jnp.einsum('btd,de->bte', h, p['w_in_odd'][j])
    q, k, v, g, y_br, x_br = split_cols(z, [D_C] * 4 + [D_D] * 2)
    sin, cos = retention_rotary(pos)
    qh = theta_shift(q.astype(f32).reshape(bsz, T, H_C, DK_C), sin, cos).transpose(0, 2, 1, 3)
    kh = (theta_shift(k.astype(f32).reshape(bsz, T, H_C, DK_C), sin, cos) * DK_C ** -0.5).transpose(0, 2, 1, 3)
    log_gamma = jnp.log1p(-jnp.exp2(-5.0 - jnp.arange(H_C, dtype=f32)))
    lg = jnp.broadcast_to(log_gamma[None, :, None, None], (bsz, H_C, T, 1))
    o_c, s_ret_new = chunked_gated_linear(qh, kh, to_heads(v, H_C), lg, s_ret)
    o_c = from_heads(head_rms(o_c)) * jax.nn.silu(g.astype(f32))
    buf = jnp.concatenate([s_conv.astype(x_br.dtype), x_br], axis=1)
    conv_new = buf[:, -(CONV_W - 1):]
    cw = p['conv_w'][j]
    xc = p['conv_b'][j] + sum(cw[m] * buf[:, m:m + T] for m in range(CONV_W))
    xc = xc.astype(f32)
    xb = xc.reshape(bsz, T, H_D, BW_D)
    rg = jax.nn.sigmoid(jnp.einsum('bthi,hij->bthj', xb, p['rglru_wa'][j]).reshape(bsz, T, D_D) + p['rglru_ba'][j])
    ig = jax.nn.sigmoid(jnp.einsum('bthi,hij->bthj', xb, p['rglru_wx'][j]).reshape(bsz, T, D_D) + p['rglru_bx'][j])
    log_a = -LRU_C * rg * jax.nn.softplus(-p['rglru_lambda'][j].astype(f32))
    a = jnp.exp(log_a)
    mult = jnp.where((pos == 0)[None, :, None], 1.0, jnp.sqrt(-jnp.expm1(2.0 * log_a)))
    hseq = linear_scan(a, mult * ig * xc, s_h.astype(f32))
    h_new = hseq[:, -1]
    o_d = hseq * jax.nn.gelu(y_br.astype(f32), approximate=True)
    o = jnp.concatenate([o_c, o_d], axis=-1).astype(h.dtype)
    out = jnp.einsum('bte,ed->btd', o, p['w_out_odd'][j])
    return out, s_ret_new, conv_new, h_new


def run_trunk(x, pos0, st_hgrn, st_rwkv, st_shift, st_ret, st_conv, st_h, p):
    T = x.shape[1]
    pos = pos0 + jnp.arange(T, dtype=jnp.int32)
    lbs = hgrn_lower_bounds(p['hgrn_lb_raw'])
    n_hgrn, n_rwkv, n_shift, n_ret, n_conv, n_h = [], [], [], [], [], []
    for l in range(DEPTH):
        hn = rms_norm(x, p['norm_mix_pre'][l])
        j = l // 2
        if l % 2 == 0:
            mix, sa, sb, sh = even_mixer(hn, lbs[j], st_hgrn[j], st_rwkv[j], st_shift[j], p, j)
            n_hgrn.append(sa.astype(st_hgrn.dtype))
            n_rwkv.append(sb.astype(st_rwkv.dtype))
            n_shift.append(sh.astype(st_shift.dtype))
        else:
            mix, sc, scv, shh = odd_mixer(hn, pos, st_ret[j], st_conv[j], st_h[j], p, j)
            n_ret.append(sc.astype(st_ret.dtype))
            n_conv.append(scv.astype(st_conv.dtype))
            n_h.append(shh.astype(st_h.dtype))
        x = x + rms_norm(mix, p['norm_mix_post'][l])
        hn = rms_norm(x, p['norm_ffn_pre'][l])
        x = x + rms_norm(swiglu(hn, p['w_ffn_in'][l], p['w_ffn_out'][l]), p['norm_ffn_post'][l])
    return x, (jnp.stack(n_hgrn), jnp.stack(n_rwkv), jnp.stack(n_shift),
               jnp.stack(n_ret), jnp.stack(n_conv), jnp.stack(n_h))


def zero_state(s, batch):
    return jnp.zeros((s.shape[0], batch) + s.shape[2:], s.dtype)


def setup_inputs(seed: int = 0) -> dict:
    key = jax.random.key(seed)
    keys = list(jax.random.split(key, 48))
    f32 = jnp.float32

    def nk():
        return keys.pop()

    def dense(shape, fan_in, s=1.0):
        return jax.random.normal(nk(), shape, f32) * (s * fan_in ** -0.5)

    def gain(shape):
        return 1.0 + 0.05 * jax.random.normal(nk(), shape, f32)

    def small(shape, s=0.02):
        return s * jax.random.normal(nk(), shape, f32)

    u = jax.random.uniform(nk(), (N_ODD, D_D), f32, 0.81, 0.998)
    sl = u ** (1.0 / LRU_C)
    lam = jnp.log(sl) - jnp.log1p(-sl)
    return {
        'x_prompt': jax.random.normal(nk(), (BATCH, SEQ, D_MODEL), f32),
        'x_sample': jax.random.normal(nk(), (DEC_BATCH, DEC_SEQ, D_MODEL), f32),
        'state_hgrn': 0.5 * jax.random.normal(nk(), (N_EVEN, DEC_BATCH, H_A, DK_A, DV_A), f32),
        'state_rwkv': 0.3 * jax.random.normal(nk(), (N_EVEN, DEC_BATCH, H_B, N_B, N_B), f32),
        'state_rwkv_shift': jax.random.normal(nk(), (N_EVEN, DEC_BATCH, D_RWKV_PROJ), f32),
        'state_ret': 0.1 * jax.random.normal(nk(), (N_ODD, DEC_BATCH, H_C, DK_C, DV_C), f32),
        'state_rglru_conv': jax.random.normal(nk(), (N_ODD, DEC_BATCH, CONV_W - 1, D_D), f32),
        'state_rglru_h': 0.5 * jax.random.normal(nk(), (N_ODD, DEC_BATCH, D_D), f32),
        'norm_mix_pre': gain((DEPTH, D_MODEL)),
        'norm_mix_post': gain((DEPTH, D_MODEL)),
        'norm_ffn_pre': gain((DEPTH, D_MODEL)),
        'norm_ffn_post': gain((DEPTH, D_MODEL)),
        'w_in_even': dense((N_EVEN, D_MODEL, D_IN_EVEN), D_MODEL),
        'w_out_even': dense((N_EVEN, D_A + D_B, D_MODEL), D_A + D_B),
        'hgrn_lb_raw': jax.random.normal(nk(), (N_EVEN, D_A), f32),
        'hgrn_norm_w': gain((N_EVEN, H_A, DV_A)),
        'rwkv_mu': jax.random.uniform(nk(), (N_EVEN, D_RWKV_PROJ), f32),
        'rwkv_w0': jax.random.uniform(nk(), (N_EVEN, D_B), f32, -5.0, 1.0),
        'rwkv_w2': dense((N_EVEN, R_W, D_B), R_W, 0.5),
        'rwkv_a0': small((N_EVEN, D_B), 0.1),
        'rwkv_a2': dense((N_EVEN, R_A, D_B), R_A, 0.5),
        'rwkv_g2': dense((N_EVEN, R_G, D_B), R_G),
        'rwkv_k_k': 0.85 + small((N_EVEN, D_B), 0.05),
        'rwkv_k_a': gain((N_EVEN, D_B)),
        'rwkv_r_k': small((N_EVEN, H_B, N_B), 0.1),
        'rwkv_ln_w': gain((N_EVEN, D_B)),
        'rwkv_ln_b': small((N_EVEN, D_B)),
        'w_in_odd': dense((N_ODD, D_MODEL, D_IN_ODD), D_MODEL),
        'w_out_odd': dense((N_ODD, D_C + D_D, D_MODEL), D_C + D_D),
        'conv_w': dense((N_ODD, CONV_W, D_D), CONV_W),
        'conv_b': small((N_ODD, D_D)),
        'rglru_wa': dense((N_ODD, H_D, BW_D, BW_D), BW_D),
        'rglru_ba': small((N_ODD, D_D)),
        'rglru_wx': dense((N_ODD, H_D, BW_D, BW_D), BW_D),
        'rglru_bx': small((N_ODD, D_D)),
        'rglru_lambda': lam,
        'w_ffn_in': dense((DEPTH, D_MODEL, 2 * D_FF), D_MODEL),
        'w_ffn_out': dense((DEPTH, D_FF, D_MODEL), D_FF),
    }


def reference(x_prompt, x_sample, state_hgrn, state_rwkv, state_rwkv_shift, state_ret,
              state_rglru_conv, state_rglru_h, norm_mix_pre, norm_mix_post, norm_ffn_pre,
              norm_ffn_post, w_in_even, w_out_even, hgrn_lb_raw, hgrn_norm_w, rwkv_mu, rwkv_w0,
              rwkv_w2, rwkv_a0, rwkv_a2, rwkv_g2, rwkv_k_k, rwkv_k_a, rwkv_r_k, rwkv_ln_w,
              rwkv_ln_b, w_in_odd, w_out_odd, conv_w, conv_b, rglru_wa, rglru_ba, rglru_wx,
              rglru_bx, rglru_lambda, w_ffn_in, w_ffn_out):
    p = dict(norm_mix_pre=norm_mix_pre, norm_mix_post=norm_mix_post, norm_ffn_pre=norm_ffn_pre,
             norm_ffn_post=norm_ffn_post, w_in_even=w_in_even, w_out_even=w_out_even,
             hgrn_lb_raw=hgrn_lb_raw, hgrn_norm_w=hgrn_norm_w, rwkv_mu=rwkv_mu, rwkv_w0=rwkv_w0,
             rwkv_w2=rwkv_w2, rwkv_a0=rwkv_a0, rwkv_a2=rwkv_a2, rwkv_g2=rwkv_g2,
             rwkv_k_k=rwkv_k_k, rwkv_k_a=rwkv_k_a, rwkv_r_k=rwkv_r_k, rwkv_ln_w=rwkv_ln_w,
             rwkv_ln_b=rwkv_ln_b, w_in_odd=w_in_odd, w_out_odd=w_out_odd, conv_w=conv_w,
             conv_b=conv_b, rglru_wa=rglru_wa, rglru_ba=rglru_ba, rglru_wx=rglru_wx,
             rglru_bx=rglru_bx, rglru_lambda=rglru_lambda, w_ffn_in=w_ffn_in, w_ffn_out=w_ffn_out)
    bp = x_prompt.shape[0]
    y_prompt, st_p = run_trunk(x_prompt, 0,
                               zero_state(state_hgrn, bp), zero_state(state_rwkv, bp),
                               zero_state(state_rwkv_shift, bp), zero_state(state_ret, bp),
                               zero_state(state_rglru_conv, bp), zero_state(state_rglru_h, bp), p)
    y_sample, st_s = run_trunk(x_sample, PAST_LEN, state_hgrn, state_rwkv, state_rwkv_shift,
                               state_ret, state_rglru_conv, state_rglru_h, p)
    hgrn_p, rwkv_p, shift_p, ret_p, conv_p, h_p = st_p
    hgrn_s, rwkv_s, shift_s, ret_s, conv_s, h_s = st_s
    return (y_prompt, y_sample, hgrn_p, hgrn_s, rwkv_p, rwkv_s, shift_p, shift_s,
            ret_p, ret_s, conv_p, conv_s, h_p, h_s)
```

```cpp
#include <hip/hip_runtime.h>
#include <cstdio>
#include <cstdint>
namespace pg8 {
#define PG8_LAS __attribute__((address_space(3)))
typedef unsigned short bf16_t;
typedef short bf16x8 __attribute__((ext_vector_type(8)));
typedef float f32x4 __attribute__((ext_vector_type(4)));
typedef unsigned u32x4 __attribute__((ext_vector_type(4)));
constexpr int BM = 256, BK = 64, HALF = 128, HTB = HALF * BK * 2  , STAGE_BYTES = 8 * HTB, NXCD = 8, WGM = 8;

__host__ __device__ __forceinline__ int lds_byte(int r, int c) { const int st = (r >> 4) * 2 + (c >> 5), rr = r & 15, cc = c & 31, ob = rr * 64 + cc * 2; return st * 1024 + (ob ^ (((ob >> 9) & 1) << 5)); }
__host__ __device__ __forceinline__ void stage_rc(int b, int& R, int& C) { const int st = b / 1024, sb = b % 1024, swz = sb ^ (((sb >> 9) & 1) << 5); R = (st >> 1) * 16 + swz / 64; C = (st & 1) * 32 + (swz % 64) / 2; }
__host__ __device__ __forceinline__ int perm32(int rho) { const int n = rho >> 4, i = rho & 15; return 8 * (i >> 2) + 4 * n + (i & 3); }

struct Unit { int pm, pn; };
struct Gemm { const bf16_t* A; const bf16_t* Bt; int M, N, K, lda, ldb, amask; };

struct StaticOrder {
    int nM, nN, nwg, G, c;
    __host__ __device__ void init(int M, int N, int G_, int c_) { nM = M / BM; nN = N / BM; nwg = nM * nN; G = G_; c = c_; }
    __host__ __device__ bool next(int i, Unit& u) const {
        const long L = (long)i * G + c; if (L >= nwg) return false;
        int wgid = (int)L; { const int q = nwg / NXCD, r = nwg % NXCD, xcd = wgid % NXCD, off = wgid / NXCD; wgid = (xcd < r ? xcd * (q + 1) : r * (q + 1) + (xcd - r) * q) + off; }
        const int nig = WGM * nN, gid = wgid / nig, fm = gid * WGM, gsz = (nM - fm) < WGM ? (nM - fm) : WGM;
        u.pm = fm + ((wgid % nig) % gsz); u.pn = (wgid % nig) / gsz; return true;
    }
    __device__ __forceinline__ void a_ready(const Unit&) const {}
    __device__ __forceinline__ void done(const Unit&) const {}
};

__device__ __forceinline__ unsigned cvt_pk_bf16(float lo, float hi) { unsigned r; asm volatile("v_cvt_pk_bf16_f32 %0, %1, %2" : "=v"(r) : "v"(lo), "v"(hi)); return r; }
typedef float f32x2 __attribute__((ext_vector_type(2)));
template <int ACT  > struct EpiBf16 {
    static constexpr bool PERM = true, AFTER_DRAIN = false; static_assert(ACT == 0, "EpiBf16: ACT is 0");
    bf16_t* O; int ldc; const float* bias; int split_cols; size_t split_stride; float scale0;
    __device__ __forceinline__ void operator()(const f32x4 (&acc)[2][2][4][2], const Unit& u, int wr, int wc, int fr, int fq) const {
        const int row0 = u.pm * BM + wr * 64 + fr; int colt = u.pn * BM; bf16_t* base = O;
        float sc = 1.f; if (split_cols) { const int t = colt / split_cols; base += (size_t)t * split_stride; colt -= t * split_cols; if (t == 0) sc = scale0; }
        const int col0 = colt + wc * 32 + 8 * fq, bcol0 = u.pn * BM + wc * 32 + 8 * fq;
        f32x4 bv[2][2];
#pragma unroll
        for (int bj = 0; bj < 2; ++bj)
#pragma unroll
            for (int n = 0; n < 2; ++n) bv[bj][n] = bias ? *(const f32x4*)(bias + bcol0 + bj * HALF + 4 * n) : (f32x4){0.f, 0.f, 0.f, 0.f};
#pragma unroll
        for (int ai = 0; ai < 2; ++ai)
#pragma unroll
            for (int m = 0; m < 4; ++m) { bf16_t* rowp = base + (size_t)(row0 + ai * HALF + m * 16) * ldc + col0;
#pragma unroll
                for (int bj = 0; bj < 2; ++bj) { f32x4 v0 = acc[ai][bj][m][0] + bv[bj][0], v1 = acc[ai][bj][m][1] + bv[bj][1];

                    v0 = v0 * sc; v1 = v1 * sc; u32x4 w; w.x = cvt_pk_bf16(v0[0], v0[1]); w.y = cvt_pk_bf16(v0[2], v0[3]); w.z = cvt_pk_bf16(v1[0], v1[1]); w.w = cvt_pk_bf16(v1[2], v1[3]);
                    *(u32x4*)(rowp + bj * HALF) = w; } }
    }
};


struct EpiF32 {
    static constexpr bool PERM = false, AFTER_DRAIN = false;
    float* C; int ldc; const float* bias;
    __device__ __forceinline__ void operator()(const f32x4 (&acc)[2][2][4][2], const Unit& u, int wr, int wc, int fr, int fq) const {
        const int row0 = u.pm * BM + wr * 64 + fr, col0 = u.pn * BM + wc * 32 + 4 * fq;
        f32x4 bv[2][2];
#pragma unroll
        for (int bj = 0; bj < 2; ++bj)
#pragma unroll
            for (int n = 0; n < 2; ++n) bv[bj][n] = bias ? *(const f32x4*)(bias + col0 + bj * HALF + n * 16) : (f32x4){0.f, 0.f, 0.f, 0.f};
#pragma unroll
        for (int ai = 0; ai < 2; ++ai)
#pragma unroll
            for (int m = 0; m < 4; ++m) { float* rowp = C + (size_t)(row0 + ai * HALF + m * 16) * ldc + col0;
#pragma unroll
                for (int bj = 0; bj < 2; ++bj)
#pragma unroll
                    for (int n = 0; n < 2; ++n) *(f32x4*)(rowp + bj * HALF + n * 16) = acc[ai][bj][m][n] + bv[bj][n]; }
    }
};
struct EpiSwiGLU {
    static constexpr bool PERM = true, AFTER_DRAIN = false;
    bf16_t* O; int ldc;
    __device__ __forceinline__ static float sw(float g, float u) { return g * u * __builtin_amdgcn_rcpf(1.0f + __builtin_amdgcn_exp2f(-1.44269504f * g)); }
    __device__ __forceinline__ void operator()(const f32x4 (&acc)[2][2][4][2], const Unit& u, int wr, int wc, int fr, int fq) const {
        const int row0 = u.pm * BM + wr * 64 + fr, col0 = u.pn * HALF + wc * 32 + 8 * fq;
#pragma unroll
        for (int ai = 0; ai < 2; ++ai)
#pragma unroll
            for (int m = 0; m < 4; ++m) { bf16_t* rowp = O + (size_t)(row0 + ai * HALF + m * 16) * ldc + col0;
                const f32x4 g0 = acc[ai][0][m][0], g1 = acc[ai][0][m][1], u0 = acc[ai][1][m][0], u1 = acc[ai][1][m][1];
                u32x4 w; w.x = cvt_pk_bf16(sw(g0[0], u0[0]), sw(g0[1], u0[1])); w.y = cvt_pk_bf16(sw(g0[2], u0[2]), sw(g0[3], u0[3]));
                w.z = cvt_pk_bf16(sw(g1[0], u1[0]), sw(g1[1], u1[1])); w.w = cvt_pk_bf16(sw(g1[2], u1[2]), sw(g1[3], u1[3]));
                *(u32x4*)rowp = w; }
    }
};
template <class Epi, class Sched, bool ALIGN_EPI = false, bool SP2 = false>
__device__ __forceinline__ void gemm_phase(PG8_LAS unsigned char* lds, const Gemm g, const Sched& S, const Epi& E) {
    int tid_ = threadIdx.x; asm volatile("" : "+v"(tid_)); const int tid = tid_, wid = __builtin_amdgcn_readfirstlane(tid >> 6), lane = tid & 63, wr = wid >> 2, wc = wid & 3, fr = lane & 15, fq = lane >> 4;
    const int K = g.K, nt = K / BK;
    unsigned voffA[2], voffB[2];
#pragma unroll
    for (int i = 0; i < 2; ++i) { int R, C; stage_rc(tid * 16 + i * 8192, R, C); const int Rb = Epi::PERM ? ((R & ~31) + perm32(R & 31)) : R;
        voffA[i] = (unsigned)(R * g.lda + C) * 2u; voffB[i] = (unsigned)(Rb * g.ldb + C) * 2u; }
    const size_t kstep = (size_t)(BK * 2);
    const size_t hstepA = (size_t)HALF * g.lda * 2, hstepB = (size_t)HALF * g.ldb * 2;
    const size_t tstepA = 2 * hstepA, tstepB = 2 * hstepB;
    const unsigned ldsw = (unsigned)wid * 1024u;
    const int aoff = lds_byte(wr * 64 + fr, fq * 8), boff = lds_byte(wc * 32 + fr, fq * 8);
#define PG8_SA(b, h) (((b) * 2 + (h)) * HTB)
#define PG8_SB(b, h) ((4 + (b) * 2 + (h)) * HTB)
#define PG8_STAGE(bufoff, gbase, voff) do { _Pragma("unroll") for (int _i = 0; _i < 2; ++_i) \
        __builtin_amdgcn_global_load_lds((const unsigned*)((const char*)(gbase) + (voff)[_i]), (PG8_LAS unsigned*)(lds + (bufoff) + ldsw + _i * 8192), 16, 0, 0); } while (0)
#define PG8_LDA(dst, b, h) do { _Pragma("unroll") for (int m = 0; m < 4; ++m) _Pragma("unroll") for (int k = 0; k < 2; ++k) dst[m][k] = *(const PG8_LAS bf16x8*)(lds + PG8_SA(b, h) + aoff + m * 2048 + k * 1024); } while (0)
#define PG8_LDB(dst, b, h) do { _Pragma("unroll") for (int n = 0; n < 2; ++n) _Pragma("unroll") for (int k = 0; k < 2; ++k) dst[n][k] = *(const PG8_LAS bf16x8*)(lds + PG8_SB(b, h) + boff + n * 2048 + k * 1024); } while (0)
#define PG8_MMA(ai, bj, At, Bt) do { __builtin_amdgcn_s_setprio(1); _Pragma("unroll") for (int m = 0; m < 4; ++m) _Pragma("unroll") for (int n = 0; n < 2; ++n) _Pragma("unroll") for (int k = 0; k < 2; ++k) \
        acc[ai][bj][m][n] = __builtin_amdgcn_mfma_f32_16x16x32_bf16(Bt[n][k], At[m][k], acc[ai][bj][m][n], 0, 0, 0); __builtin_amdgcn_s_setprio(0); } while (0)
#define PG8_WAIT_V(n) asm volatile("s_waitcnt vmcnt(" #n ")" ::: "memory")
#define PG8_WAIT_L(n) asm volatile("s_waitcnt lgkmcnt(" #n ")" ::: "memory")
#define PG8_BAR __builtin_amdgcn_s_barrier()
#define PG8_SCHED __builtin_amdgcn_sched_barrier(0)
    Unit cur, nxt; int ui = 0;
    if (!S.next(0, cur)) return;
    f32x4 acc[2][2][4][2];
#pragma unroll
    for (int a = 0; a < 2; ++a)
#pragma unroll
        for (int b = 0; b < 2; ++b)
#pragma unroll
            for (int m = 0; m < 4; ++m)
#pragma unroll
                for (int n = 0; n < 2; ++n) acc[a][b][m][n] = (f32x4){0.f, 0.f, 0.f, 0.f};
    bf16x8 At[4][2], B0[2][2], B1[2][2];
    const char* cA = (const char*)g.A + (size_t)cur.pm * tstepA + (size_t)((cur.pn & g.amask) * 512); const char* cB = (const char*)g.Bt + (size_t)cur.pn * tstepB;
    S.a_ready(cur);
    if constexpr (SP2) {
        PG8_STAGE(PG8_SB(0, 0), cB, voffB); PG8_STAGE(PG8_SB(0, 1), cB + hstepB, voffB); PG8_STAGE(PG8_SA(0, 0), cA, voffA); PG8_STAGE(PG8_SA(0, 1), cA + hstepA, voffA);
        if (wr == 1) PG8_BAR;
        PG8_WAIT_V(2); PG8_BAR;
        PG8_STAGE(PG8_SB(1, 0), cB + kstep, voffB); PG8_STAGE(PG8_SA(1, 0), cA + kstep, voffA); PG8_STAGE(PG8_SB(1, 1), cB + hstepB + kstep, voffB);
        PG8_WAIT_V(6); PG8_BAR;
    } else {
        PG8_STAGE(PG8_SB(0, 0), cB, voffB); PG8_STAGE(PG8_SA(0, 0), cA, voffA); PG8_STAGE(PG8_SB(0, 1), cB + hstepB, voffB); PG8_STAGE(PG8_SA(0, 1), cA + hstepA, voffA);
        if (wr == 1) PG8_BAR;
        PG8_WAIT_V(4); PG8_BAR;
        PG8_STAGE(PG8_SB(1, 0), cB + kstep, voffB); PG8_STAGE(PG8_SA(1, 0), cA + kstep, voffA); PG8_STAGE(PG8_SB(1, 1), cB + hstepB + kstep, voffB);
        PG8_WAIT_V(6); PG8_BAR;
    }
    for (;;) {
        const bool has_next = S.next(ui + 1, nxt);
        const char* nA = has_next ? (const char*)g.A + (size_t)nxt.pm * tstepA + (size_t)((nxt.pn & g.amask) * 512) : cA; const char* nB = has_next ? (const char*)g.Bt + (size_t)nxt.pn * tstepB : cB;
        for (int t = 0; t < nt; t += 2) {
            const bool last = (t == nt - 2);
            const char* a1 = cA + (size_t)(t + 1) * kstep;
            const char* a2 = last ? nA : cA + (size_t)(t + 2) * kstep; const char* b2 = last ? nB : cB + (size_t)(t + 2) * kstep;
            const char* a3 = a2 + kstep; const char* b3 = b2 + kstep;
            if (last && has_next) S.a_ready(nxt);
            if constexpr (SP2) {
            PG8_LDB(B0, 0, 0); PG8_LDB(B1, 0, 1); PG8_SCHED; PG8_LDA(At, 0, 0); PG8_STAGE(PG8_SA(1, 1), a1 + hstepA, voffA);
            PG8_WAIT_V(8); PG8_WAIT_L(0); PG8_BAR; PG8_MMA(0, 0, At, B0); PG8_MMA(0, 1, At, B1); PG8_BAR; PG8_SCHED;
            PG8_LDA(At, 0, 1); PG8_STAGE(PG8_SB(0, 0), b2, voffB); PG8_STAGE(PG8_SB(0, 1), b2 + hstepB, voffB); PG8_STAGE(PG8_SA(0, 0), a2, voffA);
            PG8_WAIT_V(8); PG8_WAIT_L(0); PG8_BAR; PG8_MMA(1, 0, At, B0); PG8_MMA(1, 1, At, B1); PG8_BAR; PG8_SCHED;
            PG8_LDB(B0, 1, 0); PG8_LDB(B1, 1, 1); PG8_SCHED; PG8_LDA(At, 1, 0); PG8_STAGE(PG8_SA(0, 1), a2 + hstepA, voffA);
            PG8_WAIT_V(8); PG8_WAIT_L(0); PG8_BAR; PG8_MMA(0, 0, At, B0); PG8_MMA(0, 1, At, B1); PG8_BAR; PG8_SCHED;
            PG8_LDA(At, 1, 1); PG8_STAGE(PG8_SB(1, 0), b3, voffB); PG8_STAGE(PG8_SB(1, 1), b3 + hstepB, voffB); PG8_STAGE(PG8_SA(1, 0), a3, voffA);
            PG8_WAIT_V(8); PG8_WAIT_L(0); PG8_BAR; PG8_MMA(1, 0, At, B0); PG8_MMA(1, 1, At, B1); PG8_BAR; PG8_SCHED;
            } else {
            PG8_LDB(B0, 0, 0); PG8_SCHED; PG8_LDA(At, 0, 0); PG8_STAGE(PG8_SA(1, 1), a1 + hstepA, voffA);
            PG8_WAIT_L(8); PG8_BAR; PG8_WAIT_L(0); PG8_MMA(0, 0, At, B0); PG8_BAR; PG8_SCHED;
            PG8_LDB(B1, 0, 1); PG8_STAGE(PG8_SB(0, 0), b2, voffB);
            PG8_BAR; PG8_WAIT_L(0); PG8_MMA(0, 1, At, B1); PG8_BAR;
            PG8_LDA(At, 0, 1); PG8_STAGE(PG8_SA(0, 0), a2, voffA);
            PG8_BAR; PG8_WAIT_L(0); PG8_MMA(1, 0, At, B0); PG8_BAR; PG8_SCHED;
            PG8_STAGE(PG8_SB(0, 1), b2 + hstepB, voffB);
            PG8_WAIT_V(6); PG8_BAR; PG8_MMA(1, 1, At, B1); PG8_BAR;
            PG8_LDB(B0, 1, 0); PG8_SCHED; PG8_LDA(At, 1, 0); PG8_STAGE(PG8_SA(0, 1), a2 + hstepA, voffA);
            PG8_WAIT_L(8); PG8_BAR; PG8_WAIT_L(0); PG8_MMA(0, 0, At, B0); PG8_BAR; PG8_SCHED;
            PG8_LDB(B1, 1, 1); PG8_STAGE(PG8_SB(1, 0), b3, voffB);
            PG8_BAR; PG8_WAIT_L(0); PG8_MMA(0, 1, At, B1); PG8_BAR;
            PG8_LDA(At, 1, 1); PG8_STAGE(PG8_SA(1, 0), a3, voffA);
            PG8_BAR; PG8_WAIT_L(0); PG8_MMA(1, 0, At, B0); PG8_BAR; PG8_SCHED;
            PG8_STAGE(PG8_SB(1, 1), b3 + hstepB, voffB);
            PG8_WAIT_V(6); PG8_BAR; PG8_MMA(1, 1, At, B1); PG8_BAR;
            }
        }
        if constexpr (ALIGN_EPI) { if (wr == 0) PG8_BAR; }
        if constexpr (!Epi::AFTER_DRAIN) { E(acc, cur, wr, wc, fr, fq); S.done(cur); }
        if (!has_next) break;
#pragma unroll
        for (int a = 0; a < 2; ++a)
#pragma unroll
            for (int b = 0; b < 2; ++b)
#pragma unroll
                for (int m = 0; m < 4; ++m)
#pragma unroll
                    for (int n = 0; n < 2; ++n) acc[a][b][m][n] = (f32x4){0.f, 0.f, 0.f, 0.f};
        cur = nxt; cA = nA; cB = nB; ++ui;
        if constexpr (ALIGN_EPI) { if (wr == 1) PG8_BAR; }
    }
    PG8_WAIT_V(0);
    if constexpr (!ALIGN_EPI) { if (wr == 0) PG8_BAR; }
    PG8_BAR;
    if constexpr (Epi::AFTER_DRAIN) { E.fused(acc, cur, wr, wc, fr, fq, lds, wid, lane); S.done(cur); }
#undef PG8_SA
#undef PG8_SB
#undef PG8_STAGE
#undef PG8_LDA
#undef PG8_LDB
#undef PG8_MMA
#undef PG8_WAIT_V
#undef PG8_WAIT_L
#undef PG8_BAR
#undef PG8_SCHED
}
}

constexpr int DM = 2048, NPB = 4, SEQ = 2048, NDB = 128, DSEQ = 8;
constexpr int MP = NPB * SEQ, MS = NDB * DSEQ, M = MP + MS, NSEQ = NPB + NDB;
constexpr int DINE = 7424, DINO = 6144, DRP = 3328, DFF = 5632;
constexpr float RMS_EPS = 1e-6f, GN_EPS = 64e-5f;
constexpr int NWAVES = 8, NTHR = 512;

constexpr size_t SZ_HGRN = 8 * 128 * 128, SZ_RWKV = 16 * 64 * 64, SZ_RET = 4 * 256 * 256, SZ_CONV = 3 * 1024;
constexpr size_t O_HGRN_P = (size_t)M * DM;
constexpr size_t O_HGRN_S = O_HGRN_P + 2 * NPB * SZ_HGRN;
constexpr size_t O_RWKV_P = O_HGRN_S + 2 * NDB * SZ_HGRN;
constexpr size_t O_RWKV_S = O_RWKV_P + 2 * NPB * SZ_RWKV;
constexpr size_t O_SHIFT_P = O_RWKV_S + 2 * NDB * SZ_RWKV;
constexpr size_t O_SHIFT_S = O_SHIFT_P + 2 * NPB * DRP;
constexpr size_t O_RET_P = O_SHIFT_S + 2 * NDB * DRP;
constexpr size_t O_RET_S = O_RET_P + 2 * NPB * SZ_RET;
constexpr size_t O_CONV_P = O_RET_S + 2 * NDB * SZ_RET;
constexpr size_t O_CONV_S = O_CONV_P + 2 * NPB * SZ_CONV;
constexpr size_t O_H_P = O_CONV_S + 2 * NDB * SZ_CONV;
constexpr size_t O_H_S = O_H_P + 2 * NPB * 1024;
constexpr size_t O_END = O_H_S + 2 * NDB * 1024;
static_assert(O_END == 141944832ull, "output size");

constexpr size_t WS_CTL = 0, CTL_BYTES = 1u << 20;
constexpr size_t WS_WIE = CTL_BYTES;
constexpr size_t WS_WOE = WS_WIE + 2ull * DINE * DM * 2;
constexpr size_t WS_WIO = WS_WOE + 2ull * DM * DM * 2;
constexpr size_t WS_WOO = WS_WIO + 2ull * DINO * DM * 2;
constexpr size_t WS_WFI = WS_WOO + 2ull * DM * DM * 2;
constexpr size_t WS_WFO = WS_WFI + 4ull * 2 * DFF * DM * 2;
constexpr size_t WS_WLR = WS_WFO + 4ull * DM * DFF * 2;
constexpr size_t WS_WGT = WS_WLR + 2ull * 3072 * 256 * 2;
constexpr size_t WS_BLR = WS_WGT + 2ull * 2048 * 256 * 2;
constexpr size_t WS_BGT = WS_BLR + 2ull * 3072 * 4;
constexpr size_t WS_ROT = WS_BGT + 2ull * 2048 * 4;
constexpr size_t WS_HN = WS_ROT + 2056ull * 128 * 8;
constexpr size_t WS_Z = WS_HN + (size_t)M * DM * 2;
constexpr size_t WS_O = WS_Z + (size_t)M * DINE * 2;
constexpr size_t WS_MIX = WS_O + (size_t)M * DM * 2;
constexpr size_t WS_ACT = WS_MIX + (size_t)M * DM * 4;
constexpr size_t WS_SA = WS_ACT + (size_t)M * DFF * 2;
constexpr size_t WS_SG = WS_SA + (size_t)M * 1024 * 2;
constexpr size_t WS_ORAW = WS_SG + (size_t)M * 3072 * 4;
constexpr size_t WS_YRAW = WS_ORAW + (size_t)M * 1024 * 4;
constexpr size_t WS_RK = WS_YRAW + (size_t)M * 1024 * 4;
constexpr size_t WS_END = WS_RK + (size_t)M * 16 * 4;
static_assert(WS_HN % 256 == 0 && WS_Z % 256 == 0 && WS_SG % 256 == 0, "alignment");
constexpr int CW_BAR = 4096;

constexpr int RING_OFF = 0, RING_BYTES = 131072;
constexpr int LDSCTL_OFF = RING_BYTES, MISC_OFF = LDSCTL_OFF + 320;
constexpr int LDS_BYTES = 147456;

#define GAS __attribute__((address_space(1)))
#define LAS __attribute__((address_space(3)))
typedef unsigned short bf16;
typedef unsigned v4u __attribute__((ext_vector_type(4)));
typedef unsigned v2u __attribute__((ext_vector_type(2)));
typedef float f32x4 __attribute__((ext_vector_type(4)));
typedef float f32x2 __attribute__((ext_vector_type(2)));
#define LDS_WAIT() asm volatile("s_waitcnt lgkmcnt(0)" ::: "memory")
__device__ __forceinline__ unsigned f2bf(float f) { unsigned u = __builtin_bit_cast(unsigned, f); return (u + 0x7fffu + ((u >> 16) & 1u)) >> 16; }
__device__ __forceinline__ unsigned pk2(float lo, float hi) { return f2bf(lo) | (f2bf(hi) << 16); }
__device__ __forceinline__ float bf2f(bf16 b) { return __uint_as_float((unsigned)b << 16); }
__device__ __forceinline__ float bflo(unsigned w) { return __uint_as_float(w << 16); }
__device__ __forceinline__ float bfhi(unsigned w) { return __uint_as_float(w & 0xffff0000u); }
__device__ __forceinline__ void unpack8(const v4u w, float (&f)[8]) { f[0] = bflo(w.x); f[1] = bfhi(w.x); f[2] = bflo(w.y); f[3] = bfhi(w.y); f[4] = bflo(w.z); f[5] = bfhi(w.z); f[6] = bflo(w.w); f[7] = bfhi(w.w); }
__device__ __forceinline__ v4u pack8(const float (&f)[8]) { v4u w; w.x = pk2(f[0], f[1]); w.y = pk2(f[2], f[3]); w.z = pk2(f[4], f[5]); w.w = pk2(f[6], f[7]); return w; }
__device__ __forceinline__ float sigm(float x) { return 1.0f / (1.0f + __expf(-x)); }
__device__ __forceinline__ float siluf(float x) { return x * sigm(x); }
template <int CTRL> __device__ __forceinline__ float dpp(float x) { return __builtin_bit_cast(float, __builtin_amdgcn_update_dpp(0, __builtin_bit_cast(int, x), CTRL, 0xF, 0xF, true)); }
__device__ __forceinline__ float quad_sum(float x) { x += dpp<0xB1>(x); x += dpp<0x4E>(x); return x; }
__device__ __forceinline__ float oct_sum(float x) { x = quad_sum(x); x += dpp<0x141>(x); return x; }
__device__ __forceinline__ float row16_sum(float x) { x = oct_sum(x); x += dpp<0x140>(x); return x; }
__device__ __forceinline__ float wave_sum(float v) {
#pragma unroll
    for (int o = 1; o < 64; o <<= 1) v += __shfl_xor(v, o);
    return v;
}
__device__ __forceinline__ int seq_T(int s) { return s < NPB ? SEQ : DSEQ; }
__device__ __forceinline__ int seq_row0(int s) { return s < NPB ? s * SEQ : MP + (s - NPB) * DSEQ; }
__device__ __forceinline__ void row_ts(int row, int& t, int& s) { if (row < MP) { t = row & (SEQ - 1); s = row >> 11; } else { const int r2 = row - MP; t = r2 & (DSEQ - 1); s = NPB + (r2 >> 3); } }
__device__ __forceinline__ float* st_out_ptr(float* out, size_t base_p, size_t base_s, size_t per, int j, int s) {
    return s < NPB ? out + base_p + ((size_t)j * NPB + s) * per : out + base_s + ((size_t)j * NDB + (s - NPB)) * per; }

#define XB_TMO      128
#define XB_XCNT(j)  (256  + 64 * (j))
#define XB_XSUB(j)  (1280 + 64 * (j))
#define XB_XGEN(j)  (2304 + 64 * (j))
#define XB_TOP      3328
#define XB_TOPGEN   3392
#define XCD_BAR_WORDS 3456
#define XB_SPIN_CAP (1u << 18)

__device__ __forceinline__ unsigned xb_ld(unsigned* p)              { return __hip_atomic_load(p, __ATOMIC_RELAXED, __HIP_MEMORY_SCOPE_AGENT); }
__device__ __forceinline__ unsigned xb_add(unsigned* p, unsigned v) { return __hip_atomic_fetch_add(p, v, __ATOMIC_RELAXED, __HIP_MEMORY_SCOPE_AGENT); }
__device__ __forceinline__ unsigned xb_xcc_id() { return (unsigned)__builtin_amdgcn_s_getreg((3 << 11) | 20) & 0xFu; }
#define XB_SPIN(cond, bar) do { unsigned _sp = 0; while (cond) { __builtin_amdgcn_s_sleep(1); \
    if ((++_sp & 255u) == 0u) { if (xb_ld(&(bar)[XB_TMO])) break; if (_sp > XB_SPIN_CAP) { atomicAdd(&(bar)[XB_TMO], 1u); break; } } } } while (0)

struct XcdBarrier {
    unsigned* bar; unsigned x;
    volatile LAS unsigned* st;
};

__device__ __forceinline__ XcdBarrier xcd_barrier_post(unsigned* bar, volatile LAS unsigned* st) {
    XcdBarrier b; b.bar = bar; b.x = xb_xcc_id(); b.st = st;
    if (threadIdx.x == 0) (void)xb_add(&bar[XB_XCNT(b.x)], 1u);
    return b;
}
__device__ __forceinline__ void xcd_barrier_complete(unsigned* bar, unsigned x, unsigned& nloc, unsigned& nx) {
    const unsigned G = gridDim.x * gridDim.y * gridDim.z;
    unsigned sum, cnt, mine, sp = 0u;
    for (;;) {
        sum = 0u; cnt = 0u; mine = 0u;
#pragma unroll
        for (unsigned j = 0; j < 16; ++j) { const unsigned c = xb_ld(&bar[XB_XCNT(j)]); sum += c; cnt += (c > 0u) ? 1u : 0u; mine = (j == x) ? c : mine; }
        if (sum == G) break;
        __builtin_amdgcn_s_sleep(1);
        if ((++sp & 255u) == 0u) { if (xb_ld(&bar[XB_TMO])) break; if (sp > XB_SPIN_CAP) { atomicAdd(&bar[XB_TMO], 1u); break; } }
    }
    nloc = mine > 0u ? mine : 1u; nx = cnt > 0u ? cnt : 1u;
}

__device__ __forceinline__ void xcd_barrier(const XcdBarrier& b) {
    asm volatile("s_waitcnt vmcnt(0)" ::: "memory");
    __syncthreads();
    if (threadIdx.x == 0) {
        unsigned* bar = b.bar;
        __builtin_amdgcn_s_waitcnt(0);
        unsigned nloc = b.st[0], nx = b.st[1];
        if (nloc == 0u) { xcd_barrier_complete(bar, b.x, nloc, nx); b.st[0] = nloc; b.st[1] = nx; }
        const unsigned old = xb_add(&bar[XB_XSUB(b.x)], 1u);
        const unsigned gen = old / nloc;
        if (old + 1u == (gen + 1u) * nloc) {
            __builtin_amdgcn_fence(__ATOMIC_RELEASE, "agent");
            asm volatile("s_waitcnt vmcnt(0)" ::: "memory");
            const unsigned og = xb_add(&bar[XB_TOP], 1u);
            const unsigned tg = og / nx;
            if (og + 1u == (tg + 1u) * nx) xb_add(&bar[XB_TOPGEN], 1u);
            else XB_SPIN(xb_ld(&bar[XB_TOPGEN]) == tg, bar);
            __builtin_amdgcn_fence(__ATOMIC_ACQUIRE, "agent");
            xb_add(&bar[XB_XGEN(b.x)], 1u);
            asm volatile("s_waitcnt vmcnt(0)" ::: "memory");
        } else {
            XB_SPIN(xb_ld(&bar[XB_XGEN(b.x)]) == gen, bar);
            __builtin_amdgcn_fence(__ATOMIC_ACQUIRE, "agent");
            asm volatile("s_waitcnt vmcnt(0)" ::: "memory");
        }
    }
    __syncthreads();
}


__device__ __forceinline__ void p0_transpose_item(const float* W, int K, int N, bf16* WT, int mode, LAS unsigned char* scr, int item, int lane) {
    const int nblk = N / 64, kb = item / nblk, nb = item - kb * nblk, k0 = 64 * kb, n0 = 64 * nb;
    const GAS float* src = (const GAS float*)W + (size_t)(k0 + (lane >> 4) * 16) * N + n0 + (lane & 15) * 4;
    f32x4 v[16];
#pragma unroll
    for (int i = 0; i < 16; ++i) v[i] = *(const GAS f32x4*)(src + (size_t)i * N);
#pragma unroll
    for (int e = 0; e < 4; ++e) {
        v4u a, b; a.x = pk2(v[0][e], v[1][e]); a.y = pk2(v[2][e], v[3][e]); a.z = pk2(v[4][e], v[5][e]); a.w = pk2(v[6][e], v[7][e]);
        b.x = pk2(v[8][e], v[9][e]); b.y = pk2(v[10][e], v[11][e]); b.z = pk2(v[12][e], v[13][e]); b.w = pk2(v[14][e], v[15][e]);
        LAS unsigned char* p = scr + ((lane & 15) * 4 + e) * 144 + (lane >> 4) * 32;
        *(LAS v4u*)p = a; *(LAS v4u*)(p + 16) = b;
    }
    LDS_WAIT();
    int nrow0 = n0;
    if (mode == 1) { const int up = n0 >= DFF ? 1 : 0, c = n0 - up * DFF; nrow0 = (c >> 7) * 256 + (c & 127) + up * 128; }
#pragma unroll
    for (int jj = 0; jj < 8; ++jj) { const int n = (lane >> 3) + 8 * jj;
        const v4u o = *(const LAS v4u*)(scr + n * 144 + (lane & 7) * 16);
        *(GAS v4u*)((GAS bf16*)WT + (size_t)(nrow0 + n) * K + k0 + (lane & 7) * 8) = o; }
    LDS_WAIT();
}

template <bool HAS_MIX, bool HAS_HN>
__device__ __forceinline__ void norm_row(const float* xin, const float* mix, float* xout, const float* wpost, const float* wpre, bf16* hn, int lane) {
    const GAS f32x4* xr = (const GAS f32x4*)xin + lane;
    f32x4 x[8];
#pragma unroll
    for (int jj = 0; jj < 8; ++jj) x[jj] = xr[64 * jj];
    if (HAS_MIX) {
        const GAS f32x4* mr = (const GAS f32x4*)mix + lane; const GAS f32x4* wp = (const GAS f32x4*)wpost + lane;
        f32x4 m[8]; float s = 0.f;
#pragma unroll
        for (int jj = 0; jj < 8; ++jj) { m[jj] = mr[64 * jj]; s += (m[jj].x * m[jj].x + m[jj].y * m[jj].y) + (m[jj].z * m[jj].z + m[jj].w * m[jj].w); }
        const float rs = rsqrtf(wave_sum(s) * (1.0f / DM) + RMS_EPS);
#pragma unroll
        for (int jj = 0; jj < 8; ++jj) { const f32x4 w = wp[64 * jj]; x[jj] = x[jj] + m[jj] * rs * w; }
    }
    GAS f32x4* xo = (GAS f32x4*)xout + lane;
#pragma unroll
    for (int jj = 0; jj < 8; ++jj) xo[64 * jj] = x[jj];
    if (HAS_HN) {
        float s = 0.f;
#pragma unroll
        for (int jj = 0; jj < 8; ++jj) s += (x[jj].x * x[jj].x + x[jj].y * x[jj].y) + (x[jj].z * x[jj].z + x[jj].w * x[jj].w);
        const float rs = rsqrtf(wave_sum(s) * (1.0f / DM) + RMS_EPS);
        const GAS f32x4* wq = (const GAS f32x4*)wpre + lane; GAS v2u* ho = (GAS v2u*)hn + lane;
#pragma unroll
        for (int jj = 0; jj < 8; ++jj) { const f32x4 w = wq[64 * jj]; const f32x4 y = x[jj] * rs * w; v2u o; o.x = pk2(y.x, y.y); o.y = pk2(y.z, y.w); ho[64 * jj] = o; }
    }
}

template <int VPL>
__device__ __forceinline__ void hgrn_unit(LAS float* L, const bf16* Z, int j, int s, int h, int vs, const float* st_in, float* st_out, float* ORAW, const float* lbraw, int tid) {
    constexpr int TB = VPL == 1 ? 32 : 8, NV = 16 * VPL;
    LAS float* Q = L; LAS float* K = Q + TB * 128; LAS float* F = K + TB * 128; LAS float* V = F + TB * 128; LAS float* OP = V + TB * NV;
    const int T = seq_T(s), row0 = seq_row0(s);
    const int w = tid >> 6, lane = tid & 63, vl = lane >> 2, dl = lane & 3, dk0 = 16 * w + 4 * dl;
    const int vcol0 = vs * NV + vl * VPL;
    float S[VPL][4];
#pragma unroll
    for (int c = 0; c < VPL; ++c)
#pragma unroll
        for (int e = 0; e < 4; ++e) S[c][e] = st_in ? st_in[(size_t)(dk0 + e) * 128 + vcol0 + c] : 0.f;
    const int ptt = tid >> 4, pd8 = (tid & 15) * 8;
    float lb[8];
#pragma unroll
    for (int e = 0; e < 8; ++e) lb[e] = (j == 0) ? 0.f : sigm(lbraw[1024 + h * 128 + pd8 + e] - lbraw[h * 128 + pd8 + e]);
    for (int t0 = 0; t0 < T; t0 += TB) {
        __syncthreads();
        if (ptt < TB) {
            const bf16* zr = Z + (size_t)(row0 + t0 + ptt) * DINE + h * 128 + pd8;
            float zq[8], zf[8]; unpack8(*(const GAS v4u*)zr, zq); unpack8(*(const GAS v4u*)(zr + 1024), zf);
            float q[8], k[8], f[8];
#pragma unroll
            for (int e = 0; e < 8; ++e) { q[e] = siluf(zq[e]); const float ex = __expf(-zf[e]); const float sg = 1.0f / (1.0f + ex); f[e] = lb[e] + (1.0f - lb[e]) * sg; k[e] = (1.0f - lb[e]) * (ex < 1e30f ? ex * sg : 1.0f); }
            LAS f32x4* qd = (LAS f32x4*)(Q + ptt * 128 + pd8); LAS f32x4* kd = (LAS f32x4*)(K + ptt * 128 + pd8); LAS f32x4* fd = (LAS f32x4*)(F + ptt * 128 + pd8);
            qd[0] = (f32x4){q[0], q[1], q[2], q[3]}; qd[1] = (f32x4){q[4], q[5], q[6], q[7]};
            kd[0] = (f32x4){k[0], k[1], k[2], k[3]}; kd[1] = (f32x4){k[4], k[5], k[6], k[7]};
            fd[0] = (f32x4){f[0], f[1], f[2], f[3]}; fd[1] = (f32x4){f[4], f[5], f[6], f[7]};
        }
        for (int idx = tid; idx < TB * NV; idx += NTHR) { const int tt = idx / NV, c = idx - tt * NV; V[idx] = bf2f(Z[(size_t)(row0 + t0 + tt) * DINE + 2048 + h * 128 + vs * NV + c]); }
        __syncthreads();
#pragma unroll 2
        for (int tt = 0; tt < TB; ++tt) {
            const f32x4 q4 = *(const LAS f32x4*)(Q + tt * 128 + dk0), k4 = *(const LAS f32x4*)(K + tt * 128 + dk0), f4 = *(const LAS f32x4*)(F + tt * 128 + dk0);
#pragma unroll
            for (int c = 0; c < VPL; ++c) {
                const float v = V[tt * NV + vl * VPL + c]; float o = 0.f;
#pragma unroll
                for (int e = 0; e < 4; ++e) { S[c][e] = f4[e] * S[c][e] + k4[e] * v; o += S[c][e] * q4[e]; }
                o = quad_sum(o);
                if (dl == 0) OP[(w * TB + tt) * NV + vl * VPL + c] = o;
            }
        }
        __syncthreads();
        for (int idx = tid; idx < TB * NV; idx += NTHR) { const int tt = idx / NV, c = idx - tt * NV; float o = 0.f;
#pragma unroll
            for (int ww = 0; ww < 8; ++ww) o += OP[(ww * TB + tt) * NV + c];
            ORAW[(size_t)(row0 + t0 + tt) * 1024 + h * 128 + vs * NV + c] = o; }
    }
#pragma unroll
    for (int c = 0; c < VPL; ++c)
#pragma unroll
        for (int e = 0; e < 4; ++e) st_out[(size_t)(dk0 + e) * 128 + vcol0 + c] = S[c][e];
}

struct RwkvP { const float *mu, *kk, *ka, *rk; };
template <int RPL>
__device__ __forceinline__ void rwkv_unit(LAS float* L, const bf16* Z, const float* SG, const RwkvP P, int s, int h, int rbase, bool write_rk, const float* st_shift, const float* st_in, float* st_out, float* YRAW, float* RK, int tid) {
    constexpr int TB = RPL == 1 ? 32 : 8, NR = 16 * RPL;
    LAS float* Wd = L; LAS float* KK = Wd + TB * 64; LAS float* KA = KK + TB * 64; LAS float* KB = KA + TB * 64; LAS float* R = KB + TB * 64; LAS float* Vv = R + TB * 64; LAS float* Yo = Vv + TB * NR;
    const int T = seq_T(s), row0 = seq_row0(s);
    const int w = tid >> 6, lane = tid & 63, il = tid >> 4, jp = tid & 15;
    float S[RPL][4];
    if (tid < 256) {
#pragma unroll
        for (int rr = 0; rr < RPL; ++rr) { f32x4 v = (f32x4){0.f, 0.f, 0.f, 0.f}; if (st_in) v = *(const GAS f32x4*)(st_in + (size_t)(rbase + il + 16 * rr) * 64 + 4 * jp);
            S[rr][0] = v.x; S[rr][1] = v.y; S[rr][2] = v.z; S[rr][3] = v.w; }
    }
    const int colr = h * 64 + lane;
    const float mu_r = P.mu[colr], mu_k = P.mu[1024 + colr], mu_v = P.mu[2048 + colr], c_kk = P.kk[colr], c_ka = P.ka[colr], c_rk = P.rk[colr];
    for (int t0 = 0; t0 < T; t0 += TB) {
        __syncthreads();
        for (int tt = w; tt < TB; tt += 8) {
            const int t = t0 + tt, row = row0 + t;
            const bf16* zb = Z + (size_t)row * DINE + 4096 + colr;
            const float r0 = bf2f(zb[0]), k0 = bf2f(zb[1024]), v0 = bf2f(zb[2048]);
            float pr = 0.f, pk = 0.f, pv = 0.f;
            if (t > 0) { pr = bf2f(zb[-DINE]); pk = bf2f(zb[1024 - DINE]); pv = bf2f(zb[2048 - DINE]); }
            else if (st_shift) { pr = st_shift[colr]; pk = st_shift[1024 + colr]; pv = st_shift[2048 + colr]; }
            const float r = r0 + (pr - r0) * mu_r, kb = k0 + (pk - k0) * mu_k, v = v0 + (pv - v0) * mu_v;
            const float wpre = SG[(size_t)row * 3072 + colr], apre = SG[(size_t)row * 3072 + 1024 + colr];
            const float wdec = __expf(-0.6065306597f * sigm(wpre)), a = sigm(apre);
            float kk = kb * c_kk; const float n2 = wave_sum(kk * kk); kk = kk / fmaxf(sqrtf(n2), 1e-12f);
            const float kbm = kb * (1.0f + (a - 1.0f) * c_ka);
            const float rk = wave_sum(r * kbm * c_rk);
            Wd[tt * 64 + lane] = wdec; KK[tt * 64 + lane] = kk; KA[tt * 64 + lane] = kk * a; KB[tt * 64 + lane] = kbm; R[tt * 64 + lane] = r;
            if (lane >= rbase && lane < rbase + NR) Vv[tt * NR + lane - rbase] = v;
            if (write_rk && lane == 0) RK[(size_t)row * 16 + h] = rk;
        }
        __syncthreads();
        if (tid < 256) {
#pragma unroll 2
            for (int tt = 0; tt < TB; ++tt) {
                const f32x4 w4 = *(const LAS f32x4*)(Wd + tt * 64 + 4 * jp), kk4 = *(const LAS f32x4*)(KK + tt * 64 + 4 * jp), ka4 = *(const LAS f32x4*)(KA + tt * 64 + 4 * jp),
                            kb4 = *(const LAS f32x4*)(KB + tt * 64 + 4 * jp), r4 = *(const LAS f32x4*)(R + tt * 64 + 4 * jp);
#pragma unroll
                for (int rr = 0; rr < RPL; ++rr) {
                    const float v = Vv[tt * NR + il + 16 * rr];
                    float sa = (S[rr][0] * kk4.x + S[rr][1] * kk4.y) + (S[rr][2] * kk4.z + S[rr][3] * kk4.w);
                    sa = -row16_sum(sa);
                    S[rr][0] = S[rr][0] * w4.x + (sa * ka4.x + v * kb4.x); S[rr][1] = S[rr][1] * w4.y + (sa * ka4.y + v * kb4.y);
                    S[rr][2] = S[rr][2] * w4.z + (sa * ka4.z + v * kb4.z); S[rr][3] = S[rr][3] * w4.w + (sa * ka4.w + v * kb4.w);
                    float y = (S[rr][0] * r4.x + S[rr][1] * r4.y) + (S[rr][2] * r4.z + S[rr][3] * r4.w);
                    y = row16_sum(y);
                    if (jp == 0) Yo[tt * NR + il + 16 * rr] = y;
                }
            }
        }
        __syncthreads();
        for (int idx = tid; idx < TB * NR; idx += NTHR) { const int tt = idx / NR, i = idx - tt * NR; YRAW[(size_t)(row0 + t0 + tt) * 1024 + h * 64 + rbase + i] = Yo[idx]; }
    }
    if (tid < 256) {
#pragma unroll
        for (int rr = 0; rr < RPL; ++rr) *(GAS f32x4*)(st_out + (size_t)(rbase + il + 16 * rr) * 64 + 4 * jp) = (f32x4){S[rr][0], S[rr][1], S[rr][2], S[rr][3]};
    }
}

template <int VPL>
__device__ __forceinline__ void ret_unit(LAS float* L, const bf16* Z, const f32x2* ROT, int s, int h, int vs, const float* st_in, float* st_out, float* ORAW, int tid) {
    constexpr int TB = VPL == 1 ? 32 : 8, NV = 16 * VPL;
    LAS float* Q = L; LAS float* K = Q + TB * 256; LAS float* V = K + TB * 256; LAS float* OP = V + TB * NV;
    const int T = seq_T(s), row0 = seq_row0(s), pbase = s < NPB ? 0 : 2048;
    const int w = tid >> 6, lane = tid & 63, vl = lane >> 2, dl = lane & 3, dk0 = 32 * w + 8 * dl;
    const int vcol0 = vs * NV + vl * VPL;
    const float gamma = 1.0f - exp2f(-5.0f - (float)h);
    float S[VPL][8];
#pragma unroll
    for (int c = 0; c < VPL; ++c)
#pragma unroll
        for (int e = 0; e < 8; ++e) S[c][e] = st_in ? st_in[(size_t)(dk0 + e) * 256 + vcol0 + c] : 0.f;
    for (int t0 = 0; t0 < T; t0 += TB) {
        __syncthreads();
        for (int idx = tid; idx < TB * 128; idx += NTHR) {
            const int tt = idx >> 7, pi = idx & 127; const size_t zo = (size_t)(row0 + t0 + tt) * DINO + h * 256 + 2 * pi;
            const f32x2 sc = ROT[(size_t)(pbase + t0 + tt) * 128 + pi];
            const unsigned qw = *(const GAS unsigned*)(Z + zo), kw = *(const GAS unsigned*)(Z + zo + 1024);
            const float q1 = bflo(qw), q2 = bfhi(qw), k1 = bflo(kw) * 0.0625f, k2 = bfhi(kw) * 0.0625f;
            *(LAS f32x2*)(Q + tt * 256 + 2 * pi) = (f32x2){q1 * sc.y - q2 * sc.x, q2 * sc.y + q1 * sc.x};
            *(LAS f32x2*)(K + tt * 256 + 2 * pi) = (f32x2){k1 * sc.y - k2 * sc.x, k2 * sc.y + k1 * sc.x};
        }
        for (int idx = tid; idx < TB * NV; idx += NTHR) { const int tt = idx / NV, c = idx - tt * NV; V[idx] = bf2f(Z[(size_t)(row0 + t0 + tt) * DINO + 2048 + h * 256 + vs * NV + c]); }
        __syncthreads();
#pragma unroll 2
        for (int tt = 0; tt < TB; ++tt) {
            const f32x4 qa = *(const LAS f32x4*)(Q + tt * 256 + dk0), qb = *(const LAS f32x4*)(Q + tt * 256 + dk0 + 4), ka = *(const LAS f32x4*)(K + tt * 256 + dk0), kb = *(const LAS f32x4*)(K + tt * 256 + dk0 + 4);
            const float q8[8] = {qa.x, qa.y, qa.z, qa.w, qb.x, qb.y, qb.z, qb.w}, k8[8] = {ka.x, ka.y, ka.z, ka.w, kb.x, kb.y, kb.z, kb.w};
#pragma unroll
            for (int c = 0; c < VPL; ++c) {
                const float v = V[tt * NV + vl * VPL + c]; float o = 0.f;
#pragma unroll
                for (int e = 0; e < 8; ++e) { S[c][e] = gamma * S[c][e] + k8[e] * v; o += S[c][e] * q8[e]; }
                o = quad_sum(o);
                if (dl == 0) OP[(w * TB + tt) * NV + vl * VPL + c] = o;
            }
        }
        __syncthreads();
        for (int idx = tid; idx < TB * NV; idx += NTHR) { const int tt = idx / NV, c = idx - tt * NV; float o = 0.f;
#pragma unroll
            for (int ww = 0; ww < 8; ++ww) o += OP[(ww * TB + tt) * NV + c];
            ORAW[(size_t)(row0 + t0 + tt) * 1024 + h * 256 + vs * NV + c] = o; }
    }
#pragma unroll
    for (int c = 0; c < VPL; ++c)
#pragma unroll
        for (int e = 0; e < 8; ++e) st_out[(size_t)(dk0 + e) * 256 + vcol0 + c] = S[c][e];
}

struct LruP { const float *cw, *cb, *lam; };
template <bool WRITE>
__device__ __forceinline__ f32x2 rglru_seg(const bf16* Z, const float* SG, bf16* O, const LruP P, int s, int ch, int tb, int n, float h0, const float* st_conv) {
    const int row0 = seq_row0(s); const bool prompt = s < NPB;
    const float lam_sp = log1pf(__expf(-P.lam[ch]));
    const float cw0 = P.cw[ch], cw1 = P.cw[1024 + ch], cw2 = P.cw[2048 + ch], cw3 = P.cw[3072 + ch], cb = P.cb[ch];
    float x3, x2, x1;
    {
        float tap[3];
#pragma unroll
        for (int m = 0; m < 3; ++m) { const int tm = tb - 3 + m;
            tap[m] = tm >= 0 ? bf2f(Z[(size_t)(row0 + tm) * DINO + 5120 + ch]) : (st_conv ? st_conv[(size_t)(3 + tm) * 1024 + ch] : 0.f); }
        x3 = tap[0]; x2 = tap[1]; x1 = tap[2];
    }
    float hh = h0, A = 1.0f;
    for (int t = tb; t < tb + n; ++t) {
        const size_t row = (size_t)(row0 + t);
        const float x0 = bf2f(Z[row * DINO + 5120 + ch]);
        const float xc = cb + ((cw0 * x3 + cw1 * x2) + (cw2 * x1 + cw3 * x0));
        const float rg = sigm(SG[row * 2048 + ch]), ig = sigm(SG[row * 2048 + 1024 + ch]);
        const float a = __expf(-8.0f * rg * lam_sp);
        const float mult = (prompt && t == 0) ? 1.0f : sqrtf(fmaxf(1.0f - a * a, 0.f));
        hh = a * hh + mult * ig * xc; A *= a;
        if (WRITE) { const float y = bf2f(Z[row * DINO + 4096 + ch]); const float u = 0.7978845608f * (y + 0.044715f * y * y * y);
            O[row * 2048 + 1024 + ch] = (bf16)f2bf(hh * y * sigm(2.0f * u)); }
        x3 = x2; x2 = x1; x1 = x0;
    }
    return (f32x2){A, hh};
}

#define CAS __attribute__((address_space(4)))
struct Args { const float* in[38]; float* out; unsigned char* ws; int ph_lo, ph_hi; };
__device__ __forceinline__ int opaque_tid() { int t = threadIdx.x; asm volatile("" : "+v"(t)); return t; }
__device__ __forceinline__ const CAS Args* opaque_args() { size_t z = 0; asm volatile("" : "+s"(z)); return (const CAS Args*)((const CAS char*)__builtin_amdgcn_kernarg_segment_ptr() + z); }
#ifndef MK_ONE_LAUNCH
#define MK_ONE_LAUNCH 0
#endif
#ifndef DIS_P0
#define DIS_P0 0
#endif
#ifndef DIS_A
#define DIS_A 0
#endif
#ifndef DIS_B
#define DIS_B 0
#endif
#ifndef DIS_C
#define DIS_C 0
#endif
#ifndef DIS_D
#define DIS_D 0
#endif
#ifndef DIS_E
#define DIS_E 0
#endif
#ifndef DIS_A2
#define DIS_A2 0
#endif
#ifndef DIS_F
#define DIS_F 0
#endif
#ifndef DIS_G
#define DIS_G 0
#endif
constexpr int N_PHASES = 39;

__global__ void __launch_bounds__(NTHR, 2) mega_fwd(Args args) {
    extern __shared__ __attribute__((aligned(16))) unsigned char lds_raw[];
    LAS unsigned char* lds = (LAS unsigned char*)lds_raw;
    volatile LAS unsigned* MISC = (volatile LAS unsigned*)(lds + MISC_OFF);
    const int G = gridDim.x, bx = blockIdx.x;
    for (int u = threadIdx.x; u < (LDS_BYTES - LDSCTL_OFF) / 4; u += NTHR) ((LAS unsigned*)(lds + LDSCTL_OFF))[u] = 0u;
    __syncthreads();
#if MK_ONE_LAUNCH
    XcdBarrier bar = xcd_barrier_post((unsigned*)(args.ws + WS_CTL) + CW_BAR, MISC + 8);
#define GRID_BAR() xcd_barrier(bar)
#else
#define GRID_BAR() do { } while (0)
#endif
    const int lo = args.ph_lo, hi = args.ph_hi;
    int ph = 0;
#define IN_PH (lo <= ph && ph < hi)
#define END_PH do { if (IN_PH && (ph + 1) < hi) GRID_BAR(); ++ph; } while (0)

#define PHASE_ENV \
    const int tid = opaque_tid(); const int lane = tid & 63, wave = __builtin_amdgcn_readfirstlane(tid >> 6); \
    const int gw = bx * NWAVES + wave, NGW = G * NWAVES, gt = bx * NTHR + tid, NGT = G * NTHR; (void)gw; (void)NGW; (void)gt; (void)NGT; (void)lane; \
    const CAS Args* ap = opaque_args(); unsigned char* ws = ap->ws; float* out = ap->out; (void)out; \
    bf16* HN = (bf16*)(ws + WS_HN); bf16* Z = (bf16*)(ws + WS_Z); bf16* OB = (bf16*)(ws + WS_O); float* MIX = (float*)(ws + WS_MIX); bf16* ACT = (bf16*)(ws + WS_ACT); \
    bf16* SA = (bf16*)(ws + WS_SA); float* SG = (float*)(ws + WS_SG); float* ORAW = (float*)(ws + WS_ORAW); float* YRAW = (float*)(ws + WS_YRAW); float* RKB = (float*)(ws + WS_RK); \
    const f32x2* ROT = (const f32x2*)(ws + WS_ROT); (void)HN; (void)Z; (void)OB; (void)MIX; (void)ACT; (void)SA; (void)SG; (void)ORAW; (void)YRAW; (void)RKB; (void)ROT;
#define AIN(k) (ap->in[k])

    if (IN_PH && !DIS_P0) { PHASE_ENV
        LAS unsigned char* scr = lds + RING_OFF + wave * 9216;
        constexpr int I_IE = (DM / 64) * (DINE / 64), I_OE = (DM / 64) * (DM / 64), I_IO = (DM / 64) * (DINO / 64), I_FI = (DM / 64) * (2 * DFF / 64), I_FO = (DFF / 64) * (DM / 64);
        constexpr int NITEMS = 2 * I_IE + 2 * I_OE + 2 * I_IO + 2 * I_OE + 4 * I_FI + 4 * I_FO;
        for (int it = gw; it < NITEMS; it += NGW) {
            int r = it;
            if (r < 2 * I_IE) { const int l = r / I_IE; p0_transpose_item(AIN(12) + (size_t)l * DM * DINE, DM, DINE, (bf16*)(ws + WS_WIE) + (size_t)l * DINE * DM, 0, scr, r - l * I_IE, lane); continue; } r -= 2 * I_IE;
            if (r < 2 * I_OE) { const int l = r / I_OE; p0_transpose_item(AIN(13) + (size_t)l * DM * DM, DM, DM, (bf16*)(ws + WS_WOE) + (size_t)l * DM * DM, 0, scr, r - l * I_OE, lane); continue; } r -= 2 * I_OE;
            if (r < 2 * I_IO) { const int l = r / I_IO; p0_transpose_item(AIN(27) + (size_t)l * DM * DINO, DM, DINO, (bf16*)(ws + WS_WIO) + (size_t)l * DINO * DM, 0, scr, r - l * I_IO, lane); continue; } r -= 2 * I_IO;
            if (r < 2 * I_OE) { const int l = r / I_OE; p0_transpose_item(AIN(28) + (size_t)l * DM * DM, DM, DM, (bf16*)(ws + WS_WOO) + (size_t)l * DM * DM, 0, scr, r - l * I_OE, lane); continue; } r -= 2 * I_OE;
            if (r < 4 * I_FI) { const int l = r / I_FI; p0_transpose_item(AIN(36) + (size_t)l * DM * 2 * DFF, DM, 2 * DFF, (bf16*)(ws + WS_WFI) + (size_t)l * 2 * DFF * DM, 1, scr, r - l * I_FI, lane); continue; } r -= 4 * I_FI;
            { const int l = r / I_FO; p0_transpose_item(AIN(37) + (size_t)l * DFF * DM, DFF, DM, (bf16*)(ws + WS_WFO) + (size_t)l * DM * DFF, 0, scr, r - l * I_FO, lane); }
        }
        for (int idx = gt; idx < 2 * 3072 * 256; idx += NGT) { const int jj = idx / (3072 * 256), r = idx - jj * 3072 * 256, n = r >> 8, k = r & 255; float v = 0.f;
            if (n < 1024) { if (k < 64) v = AIN(18)[((size_t)jj * 64 + k) * 1024 + n]; }
            else if (n < 2048) { if (k >= 64 && k < 128) v = AIN(20)[((size_t)jj * 64 + (k - 64)) * 1024 + (n - 1024)]; }
            else { if (k >= 128) v = AIN(21)[((size_t)jj * 128 + (k - 128)) * 1024 + (n - 2048)]; }
            ((bf16*)(ws + WS_WLR))[idx] = (bf16)f2bf(v); }
        for (int idx = gt; idx < 2 * 3072; idx += NGT) { const int jj = idx / 3072, n = idx - jj * 3072;
            ((float*)(ws + WS_BLR))[idx] = n < 1024 ? AIN(17)[jj * 1024 + n] : (n < 2048 ? AIN(19)[jj * 1024 + n - 1024] : 0.f); }
        for (int idx = gt; idx < 2 * 2048 * 256; idx += NGT) { const int jj = idx / (2048 * 256), r = idx - jj * 2048 * 256, n = r >> 8, k = r & 255, n2 = n & 1023, hd = n2 >> 8, jc = n2 & 255;
            const float* src = n < 1024 ? AIN(31) : AIN(33);
            ((bf16*)(ws + WS_WGT))[idx] = (bf16)f2bf(src[(((size_t)jj * 4 + hd) * 256 + k) * 256 + jc]); }
        for (int idx = gt; idx < 2 * 2048; idx += NGT) { const int jj = idx / 2048, n = idx - jj * 2048;
            ((float*)(ws + WS_BGT))[idx] = n < 1024 ? AIN(32)[jj * 1024 + n] : AIN(34)[jj * 1024 + n - 1024]; }
        for (int idx = gt; idx < 2056 * 128; idx += NGT) { const int pi = idx >> 7, i = idx & 127; const double pos = pi < 2048 ? (double)pi : (double)(16384 + pi - 2048);
            const double ang = pos * exp(-9.210340371976184 * ((double)i / 127.0));
            ((f32x2*)(ws + WS_ROT))[idx] = (f32x2){(float)sin(ang), (float)cos(ang)}; }
        for (int row = gw; row < M; row += NGW) {
            const float* xin = row < MP ? AIN(0) + (size_t)row * DM : AIN(1) + (size_t)(row - MP) * DM;
            norm_row<false, true>(xin, nullptr, out + (size_t)row * DM, nullptr, AIN(8), HN + (size_t)row * DM, lane);
        }
    }
    END_PH;

    for (int hl = 0; hl < 8; ++hl) {
        const int l = hl >> 1, j = l >> 1; const bool mixer = (hl & 1) == 0, even = (l & 1) == 0;
        if (mixer) {
            if (IN_PH && !DIS_A) { PHASE_ENV
                const int N = even ? DINE : DINO;
                const bf16* Bt = even ? (const bf16*)(ws + WS_WIE) + (size_t)j * DINE * DM : (const bf16*)(ws + WS_WIO) + (size_t)j * DINO * DM;
                pg8::Gemm g{HN, Bt, M, N, DM, DM, DM, 0}; pg8::StaticOrder S; S.init(M, N, G, bx);
                pg8::EpiBf16<0> E{Z, N, nullptr, 0, 0, 1.f};
                pg8::gemm_phase<pg8::EpiBf16<0>, pg8::StaticOrder, true, true>(lds + RING_OFF, g, S, E);
            }
            END_PH;
            if (IN_PH && !DIS_B) { PHASE_ENV
                LAS float* L = (LAS float*)(lds + RING_OFF);
                if (even) {
                    const float* mu = AIN(16) + (size_t)j * DRP; const float* st_shift = AIN(4) + (size_t)j * NDB * DRP;
                    for (int idx = gt; idx < M * 32; idx += NGT) {
                        const int row = idx >> 5, c8 = idx & 31; int t, s; row_ts(row, t, s);
                        const bf16* zr = Z + (size_t)row * DINE + 7168 + c8 * 8;
                        float c[8], p[8]; unpack8(*(const GAS v4u*)zr, c);
                        if (t > 0) unpack8(*(const GAS v4u*)(zr - DINE), p);
                        else {
#pragma unroll
                            for (int e = 0; e < 8; ++e) p[e] = s >= NPB ? st_shift[(size_t)(s - NPB) * DRP + 3072 + c8 * 8 + e] : 0.f; }
                        float o[8];
#pragma unroll
                        for (int e = 0; e < 8; ++e) { const float zs = c[e] + (p[e] - c[e]) * mu[3072 + c8 * 8 + e];
                            o[e] = c8 < 8 ? 2.0f * sigm(2.0f * zs) - 1.0f : (c8 < 16 ? zs : sigm(zs)); }
                        *(GAS v4u*)(SA + (size_t)row * 256 + c8 * 8) = pack8(o);
                    }
                    for (int idx = gt; idx < NSEQ * DRP; idx += NGT) { const int s = idx / DRP, c = idx - s * DRP;
                        st_out_ptr(out, O_SHIFT_P, O_SHIFT_S, DRP, j, s)[c] = bf2f(Z[(size_t)(seq_row0(s) + seq_T(s) - 1) * DINE + 4096 + c]); }
                    const float* lbraw = AIN(14);
                    for (int u = bx; u < 256 + 1024; u += G) {
                        if (u < 256) { const int s = u >> 6, h = (u >> 3) & 7, vs = u & 7;
                            hgrn_unit<1>(L, Z, j, s, h, vs, nullptr, st_out_ptr(out, O_HGRN_P, O_HGRN_S, SZ_HGRN, j, s) + (size_t)h * 16384, ORAW, lbraw, tid); }
                        else { const int u2 = u - 256, b = u2 >> 3, h = u2 & 7, s = NPB + b;
                            hgrn_unit<8>(L, Z, j, s, h, 0, AIN(2) + ((size_t)j * NDB + b) * SZ_HGRN + (size_t)h * 16384, st_out_ptr(out, O_HGRN_P, O_HGRN_S, SZ_HGRN, j, s) + (size_t)h * 16384, ORAW, lbraw, tid); }
                    }
                } else {
                    const float* cw = AIN(29) + (size_t)j * 4 * 1024; const float* cb = AIN(30) + (size_t)j * 1024; const float* st_conv = AIN(6) + (size_t)j * NDB * SZ_CONV;
                    for (int idx = gt; idx < M * 128; idx += NGT) {
                        const int row = idx >> 7, c8 = idx & 127, c0 = c8 * 8; int t, s; row_ts(row, t, s);
                        float acc[8];
#pragma unroll
                        for (int e = 0; e < 8; ++e) acc[e] = cb[c0 + e];
#pragma unroll
                        for (int m = 0; m < 4; ++m) { const int tm = t - 3 + m; float x[8];
                            if (tm >= 0) unpack8(*(const GAS v4u*)(Z + (size_t)(row - 3 + m) * DINO + 5120 + c0), x);
                            else {
#pragma unroll
                                for (int e = 0; e < 8; ++e) x[e] = s >= NPB ? st_conv[(size_t)(s - NPB) * SZ_CONV + (size_t)(3 + tm) * 1024 + c0 + e] : 0.f; }
#pragma unroll
                            for (int e = 0; e < 8; ++e) acc[e] += cw[m * 1024 + c0 + e] * x[e]; }
                        *(GAS v4u*)(SA + (size_t)row * 1024 + c0) = pack8(acc);
                    }
                    for (int idx = gt; idx < NSEQ * 3 * 1024; idx += NGT) { const int s = idx / 3072, r = (idx - s * 3072) >> 10, c = idx & 1023;
                        st_out_ptr(out, O_CONV_P, O_CONV_S, SZ_CONV, j, s)[r * 1024 + c] = bf2f(Z[(size_t)(seq_row0(s) + seq_T(s) - 3 + r) * DINO + 5120 + c]); }
                    for (int u = bx; u < 256 + 1024; u += G) {
                        if (u < 256) { const int s = u >> 6, h = (u >> 4) & 3, vs = u & 15;
                            ret_unit<1>(L, Z, ROT, s, h, vs, nullptr, st_out_ptr(out, O_RET_P, O_RET_S, SZ_RET, j, s) + (size_t)h * 65536, ORAW, tid); }
                        else { const int u2 = u - 256, b = u2 >> 3, h = (u2 >> 1) & 3, vs = u2 & 1, s = NPB + b;
                            ret_unit<8>(L, Z, ROT, s, h, vs, AIN(5) + ((size_t)j * NDB + b) * SZ_RET + (size_t)h * 65536, st_out_ptr(out, O_RET_P, O_RET_S, SZ_RET, j, s) + (size_t)h * 65536, ORAW, tid); }
                    }
                }
            }
            END_PH;
            if (IN_PH && !DIS_C) { PHASE_ENV
                const int N = even ? 3072 : 2048;
                const bf16* Bt = even ? (const bf16*)(ws + WS_WLR) + (size_t)j * 3072 * 256 : (const bf16*)(ws + WS_WGT) + (size_t)j * 2048 * 256;
                const float* bias = even ? (const float*)(ws + WS_BLR) + j * 3072 : (const float*)(ws + WS_BGT) + j * 2048;
                pg8::Gemm g{SA, Bt, M, N, 256, even ? 256 : 1024, 256, even ? 0 : 3}; pg8::StaticOrder S; S.init(M, N, G, bx);
                pg8::EpiF32 E{SG, N, bias};
                pg8::gemm_phase<pg8::EpiF32, pg8::StaticOrder, true, true>(lds + RING_OFF, g, S, E);
            }
            END_PH;
            if (IN_PH && !DIS_D) { PHASE_ENV
                LAS float* L = (LAS float*)(lds + RING_OFF);
                if (even) {
                    const RwkvP P{AIN(16) + (size_t)j * DRP, AIN(22) + (size_t)j * 1024, AIN(23) + (size_t)j * 1024, AIN(24) + (size_t)j * 1024};
                    for (int u = bx; u < 256 + 2048; u += G) {
                        if (u < 256) { const int s = u >> 6, h = (u >> 2) & 15, sl = u & 3;
                            rwkv_unit<1>(L, Z, SG, P, s, h, sl * 16, sl == 0, nullptr, nullptr, st_out_ptr(out, O_RWKV_P, O_RWKV_S, SZ_RWKV, j, s) + (size_t)h * 4096, YRAW, RKB, tid); }
                        else { const int u2 = u - 256, b = u2 >> 4, h = u2 & 15, s = NPB + b;
                            rwkv_unit<4>(L, Z, SG, P, s, h, 0, true, AIN(4) + ((size_t)j * NDB + b) * DRP, AIN(3) + ((size_t)j * NDB + b) * SZ_RWKV + (size_t)h * 4096,
                                         st_out_ptr(out, O_RWKV_P, O_RWKV_S, SZ_RWKV, j, s) + (size_t)h * 4096, YRAW, RKB, tid); }
                    }
                } else {
                    for (int row = gw; row < M; row += NGW) {
                        const GAS f32x4* orow = (const GAS f32x4*)(ORAW + (size_t)row * 1024 + 16 * lane);
                        float o[16];
#pragma unroll
                        for (int q = 0; q < 4; ++q) { const f32x4 v = orow[q]; o[4 * q] = v.x; o[4 * q + 1] = v.y; o[4 * q + 2] = v.z; o[4 * q + 3] = v.w; }
                        float ss = 0.f;
#pragma unroll
                        for (int e = 0; e < 16; ++e) ss += o[e] * o[e];
                        const float rs = rsqrtf(row16_sum(ss) * (1.0f / 256.0f) + RMS_EPS);
                        float g[16]; { float t8[8]; unpack8(*(const GAS v4u*)(Z + (size_t)row * DINO + 3072 + 16 * lane), t8);
#pragma unroll
                            for (int e = 0; e < 8; ++e) g[e] = t8[e];
                            unpack8(*(const GAS v4u*)(Z + (size_t)row * DINO + 3072 + 16 * lane + 8), t8);
#pragma unroll
                            for (int e = 0; e < 8; ++e) g[8 + e] = t8[e]; }
                        float r0[8], r1[8];
#pragma unroll
                        for (int e = 0; e < 8; ++e) { r0[e] = o[e] * rs * siluf(g[e]); r1[e] = o[8 + e] * rs * siluf(g[8 + e]); }
                        *(GAS v4u*)(OB + (size_t)row * DM + 16 * lane) = pack8(r0); *(GAS v4u*)(OB + (size_t)row * DM + 16 * lane + 8) = pack8(r1);
                    }
                    const LruP P{AIN(29) + (size_t)j * 4 * 1024, AIN(30) + (size_t)j * 1024, AIN(35) + (size_t)j * 1024};
                    for (int u = bx; u < 256; u += G) {
                        const int s = u >> 6, cg = u & 63, cl = tid & 15, ch = cg * 16 + cl, chunk = tid >> 4;
                        __syncthreads();
                        const f32x2 ah = rglru_seg<false>(Z, SG, OB, P, s, ch, chunk * 64, 64, 0.f, nullptr);
                        L[chunk * 16 + cl] = ah.x; L[512 + chunk * 16 + cl] = ah.y;
                        __syncthreads();
                        float hin = 0.f;
                        for (int c2 = 0; c2 < chunk; ++c2) hin = L[c2 * 16 + cl] * hin + L[512 + c2 * 16 + cl];
                        const f32x2 r = rglru_seg<true>(Z, SG, OB, P, s, ch, chunk * 64, 64, hin, nullptr);
                        if (chunk == 31) st_out_ptr(out, O_H_P, O_H_S, 1024, j, s)[ch] = r.y;
                    }
                    for (int idx = gt; idx < NDB * 1024; idx += NGT) { const int b = idx >> 10, ch = idx & 1023, s = NPB + b;
                        const f32x2 r = rglru_seg<true>(Z, SG, OB, P, s, ch, 0, DSEQ, AIN(7)[((size_t)j * NDB + b) * 1024 + ch], AIN(6) + ((size_t)j * NDB + b) * SZ_CONV);
                        st_out_ptr(out, O_H_P, O_H_S, 1024, j, s)[ch] = r.y; }
                }
            }
            END_PH;
            if (even) {
                if (IN_PH && !DIS_E) { PHASE_ENV
                    const float* nw = AIN(15) + (size_t)j * 1024; const float* lnw = AIN(25) + (size_t)j * 1024; const float* lnb = AIN(26) + (size_t)j * 1024;
                    const float* mu = AIN(16) + (size_t)j * DRP + 2048; const float* st_shift = AIN(4) + (size_t)j * NDB * DRP;
                    for (int row = gw; row < M; row += NGW) {
                        int t, s; row_ts(row, t, s);
                        const int c0 = 16 * lane;
                        {
                            const GAS f32x4* orow = (const GAS f32x4*)(ORAW + (size_t)row * 1024 + c0);
                            float o[16];
#pragma unroll
                            for (int q = 0; q < 4; ++q) { const f32x4 v = orow[q]; o[4 * q] = v.x; o[4 * q + 1] = v.y; o[4 * q + 2] = v.z; o[4 * q + 3] = v.w; }
                            float ss = 0.f;
#pragma unroll
                            for (int e = 0; e < 16; ++e) ss += o[e] * o[e];
                            const float rs = rsqrtf(oct_sum(ss) * (1.0f / 128.0f) + RMS_EPS);
                            float g0[8], g1[8]; unpack8(*(const GAS v4u*)(Z + (size_t)row * DINE + 3072 + c0), g0); unpack8(*(const GAS v4u*)(Z + (size_t)row * DINE + 3072 + c0 + 8), g1);
                            float r0[8], r1[8];
#pragma unroll
                            for (int e = 0; e < 8; ++e) { r0[e] = o[e] * rs * nw[c0 + e] * siluf(g0[e]); r1[e] = o[8 + e] * rs * nw[c0 + 8 + e] * siluf(g1[e]); }
                            *(GAS v4u*)(OB + (size_t)row * DM + c0) = pack8(r0); *(GAS v4u*)(OB + (size_t)row * DM + c0 + 8) = pack8(r1);
                        }
                        {
                            const GAS f32x4* yrow = (const GAS f32x4*)(YRAW + (size_t)row * 1024 + c0);
                            float y[16];
#pragma unroll
                            for (int q = 0; q < 4; ++q) { const f32x4 v = yrow[q]; y[4 * q] = v.x; y[4 * q + 1] = v.y; y[4 * q + 2] = v.z; y[4 * q + 3] = v.w; }
                            float sm = 0.f;
#pragma unroll
                            for (int e = 0; e < 16; ++e) sm += y[e];
                            const float mean = quad_sum(sm) * (1.0f / 64.0f); float sv = 0.f;
#pragma unroll
                            for (int e = 0; e < 16; ++e) { const float d = y[e] - mean; sv += d * d; }
                            const float rstd = rsqrtf(quad_sum(sv) * (1.0f / 64.0f) + GN_EPS);
                            const bf16* zv = Z + (size_t)row * DINE + 4096 + 2048 + c0;
                            float v0[8], v1[8], p0[8], p1[8]; unpack8(*(const GAS v4u*)zv, v0); unpack8(*(const GAS v4u*)(zv + 8), v1);
                            if (t > 0) { unpack8(*(const GAS v4u*)(zv - DINE), p0); unpack8(*(const GAS v4u*)(zv - DINE + 8), p1); }
                            else {
#pragma unroll
                                for (int e = 0; e < 8; ++e) { p0[e] = s >= NPB ? st_shift[(size_t)(s - NPB) * DRP + 2048 + c0 + e] : 0.f; p1[e] = s >= NPB ? st_shift[(size_t)(s - NPB) * DRP + 2048 + c0 + 8 + e] : 0.f; } }
                            const float rk = RKB[(size_t)row * 16 + (lane >> 2)];
                            const GAS f32x4* grow = (const GAS f32x4*)(SG + (size_t)row * 3072 + 2048 + c0);
                            float gt_[16];
#pragma unroll
                            for (int q = 0; q < 4; ++q) { const f32x4 v = grow[q]; gt_[4 * q] = v.x; gt_[4 * q + 1] = v.y; gt_[4 * q + 2] = v.z; gt_[4 * q + 3] = v.w; }
                            float r0[8], r1[8];
#pragma unroll
                            for (int e = 0; e < 8; ++e) {
                                const float va = v0[e] + (p0[e] - v0[e]) * mu[c0 + e], vb = v1[e] + (p1[e] - v1[e]) * mu[c0 + 8 + e];
                                r0[e] = ((y[e] - mean) * rstd * lnw[c0 + e] + lnb[c0 + e] + rk * va) * gt_[e];
                                r1[e] = ((y[8 + e] - mean) * rstd * lnw[c0 + 8 + e] + lnb[c0 + 8 + e] + rk * vb) * gt_[8 + e]; }
                            *(GAS v4u*)(OB + (size_t)row * DM + 1024 + c0) = pack8(r0); *(GAS v4u*)(OB + (size_t)row * DM + 1024 + c0 + 8) = pack8(r1);
                        }
                    }
                }
                END_PH;
            }
        } else {
            if (IN_PH && !DIS_A2) { PHASE_ENV
                pg8::Gemm g{HN, (const bf16*)(ws + WS_WFI) + (size_t)l * 2 * DFF * DM, M, 2 * DFF, DM, DM, DM, 0}; pg8::StaticOrder S; S.init(M, 2 * DFF, G, bx);
                pg8::EpiSwiGLU E{ACT, DFF};
                pg8::gemm_phase<pg8::EpiSwiGLU, pg8::StaticOrder, true, true>(lds + RING_OFF, g, S, E);
            }
            END_PH;
        }
        if (IN_PH && !DIS_F) { PHASE_ENV
            const bf16* A = mixer ? OB : ACT; const int K = mixer ? DM : DFF;
            const bf16* Bt = mixer ? (even ? (const bf16*)(ws + WS_WOE) : (const bf16*)(ws + WS_WOO)) + (size_t)j * DM * DM : (const bf16*)(ws + WS_WFO) + (size_t)l * DM * DFF;
            pg8::Gemm g{A, Bt, M, DM, K, K, K, 0}; pg8::StaticOrder S; S.init(M, DM, G, bx);
            pg8::EpiF32 E{MIX, DM, nullptr};
            pg8::gemm_phase<pg8::EpiF32, pg8::StaticOrder, true, true>(lds + RING_OFF, g, S, E);
        }
        END_PH;
        if (IN_PH && !DIS_G) { PHASE_ENV
            const float* wpost = (mixer ? AIN(9) : AIN(11)) + (size_t)l * DM;
            const float* wpre = mixer ? AIN(10) + (size_t)l * DM : AIN(8) + (size_t)(l + 1 < 4 ? l + 1 : 0) * DM;
            if (hl < 7) { for (int row = gw; row < M; row += NGW) norm_row<true, true>(out + (size_t)row * DM, MIX + (size_t)row * DM, out + (size_t)row * DM, wpost, wpre, HN + (size_t)row * DM, lane); }
            else { for (int row = gw; row < M; row += NGW) norm_row<true, false>(out + (size_t)row * DM, MIX + (size_t)row * DM, out + (size_t)row * DM, wpost, wpre, HN + (size_t)row * DM, lane); }
        }
        END_PH;
    }
}

extern "C" void kernel_launch(void* const* d_in, const int* in_sizes, int n_in, void* d_out, int out_size, void* d_ws, size_t ws_size, hipStream_t stream) {
    static int grid = 0;
    if (grid == 0) {
        if (n_in != 38 || (size_t)out_size != O_END || ws_size < WS_END) { fprintf(stderr, "kernel_launch: unexpected sizes: n_in %d out %d ws %zu (need %zu)\n", n_in, out_size, ws_size, (size_t)WS_END); grid = -1; return; }
        int dev = 0, cus = 0, per_cu = 0;
        if (hipGetDevice(&dev) != hipSuccess || hipDeviceGetAttribute(&cus, hipDeviceAttributeMultiprocessorCount, dev) != hipSuccess) { grid = -1; return; }
        if (hipFuncSetAttribute((const void*)mega_fwd, hipFuncAttributeMaxDynamicSharedMemorySize, LDS_BYTES) != hipSuccess) { fprintf(stderr, "kernel_launch: hipFuncSetAttribute failed\n"); grid = -1; return; }
        if (hipOccupancyMaxActiveBlocksPerMultiprocessor(&per_cu, (const void*)mega_fwd, NTHR, LDS_BYTES) != hipSuccess || per_cu < 1) fprintf(stderr, "kernel_launch: occupancy query says %d\n", per_cu);
        (void)hipGetLastError();
        grid = cus;
    }
    if (grid < 0) return;
    (void)hipMemsetAsync((char*)d_ws + WS_CTL, 0, CTL_BYTES, stream);
    Args a{};
    for (int i = 0; i < 38; ++i) a.in[i] = (const float*)d_in[i];
    a.out = (float*)d_out; a.ws = (unsigned char*)d_ws;
#if MK_ONE_LAUNCH
    a.ph_lo = 0; a.ph_hi = N_PHASES;
    hipLaunchKernelGGL(mega_fwd, dim3(grid), dim3(NTHR), LDS_BYTES, stream, a);
#else
    for (int p = 0; p < N_PHASES; ++p) { a.ph_lo = p; a.ph_hi = p + 1; hipLaunchKernelGGL(mega_fwd, dim3(grid), dim3(NTHR), LDS_BYTES, stream, a); }
#endif
}
```

```cpp
#include <hip/hip_runtime.h>
#include <cstdio>
#include <cstdint>
namespace pg8 {
#define PG8_LAS __attribute__((address_space(3)))
typedef unsigned short bf16_t;
typedef short bf16x8 __attribute__((ext_vector_type(8)));
typedef float f32x4 __attribute__((ext_vector_type(4)));
typedef unsigned u32x4 __attribute__((ext_vector_type(4)));
constexpr int BM = 256, BK = 64, HALF = 128, HTB = HALF * BK * 2  , STAGE_BYTES = 8 * HTB, NXCD = 8, WGM = 8;

__host__ __device__ __forceinline__ int lds_byte(int r, int c) { const int st = (r >> 4) * 2 + (c >> 5), rr = r & 15, cc = c & 31, ob = rr * 64 + cc * 2; return st * 1024 + (ob ^ (((ob >> 9) & 1) << 5)); }
__host__ __device__ __forceinline__ void stage_rc(int b, int& R, int& C) { const int st = b / 1024, sb = b % 1024, swz = sb ^ (((sb >> 9) & 1) << 5); R = (st >> 1) * 16 + swz / 64; C = (st & 1) * 32 + (swz % 64) / 2; }
__host__ __device__ __forceinline__ int perm32(int rho) { const int n = rho >> 4, i = rho & 15; return 8 * (i >> 2) + 4 * n + (i & 3); }

struct Unit { int pm, pn; };
struct Gemm { const bf16_t* A; const bf16_t* Bt; int M, N, K, lda, ldb, amask; };

struct StaticOrder {
    int nM, nN, nwg, G, c;
    __host__ __device__ void init(int M, int N, int G_, int c_) { nM = M / BM; nN = N / BM; nwg = nM * nN; G = G_; c = c_; }
    __host__ __device__ bool next(int i, Unit& u) const {
        const long L = (long)i * G + c; if (L >= nwg) return false;
        int wgid = (int)L; { const int q = nwg / NXCD, r = nwg % NXCD, xcd = wgid % NXCD, off = wgid / NXCD; wgid = (xcd < r ? xcd * (q + 1) : r * (q + 1) + (xcd - r) * q) + off; }
        const int nig = WGM * nN, gid = wgid / nig, fm = gid * WGM, gsz = (nM - fm) < WGM ? (nM - fm) : WGM;
        u.pm = fm + ((wgid % nig) % gsz); u.pn = (wgid % nig) / gsz; return true;
    }
    __device__ __forceinline__ void a_ready(const Unit&) const {}
    __device__ __forceinline__ void done(const Unit&) const {}
};

__device__ __forceinline__ unsigned cvt_pk_bf16(float lo, float hi) { unsigned r; asm volatile("v_cvt_pk_bf16_f32 %0, %1, %2" : "=v"(r) : "v"(lo), "v"(hi)); return r; }
typedef float f32x2 __attribute__((ext_vector_type(2)));
template <int ACT  > struct EpiBf16 {
    static constexpr bool PERM = true, AFTER_DRAIN = false; static_assert(ACT == 0, "EpiBf16: ACT is 0");
    bf16_t* O; int ldc; const float* bias; int split_cols; size_t split_stride; float scale0;
    __device__ __forceinline__ void operator()(const f32x4 (&acc)[2][2][4][2], const Unit& u, int wr, int wc, int fr, int fq) const {
        const int row0 = u.pm * BM + wr * 64 + fr; int colt = u.pn * BM; bf16_t* base = O;
        float sc = 1.f; if (split_cols) { const int t = colt / split_cols; base += (size_t)t * split_stride; colt -= t * split_cols; if (t == 0) sc = scale0; }
        const int col0 = colt + wc * 32 + 8 * fq, bcol0 = u.pn * BM + wc * 32 + 8 * fq;
        f32x4 bv[2][2];
#pragma unroll
        for (int bj = 0; bj < 2; ++bj)
#pragma unroll
            for (int n = 0; n < 2; ++n) bv[bj][n] = bias ? *(const f32x4*)(bias + bcol0 + bj * HALF + 4 * n) : (f32x4){0.f, 0.f, 0.f, 0.f};
#pragma unroll
        for (int ai = 0; ai < 2; ++ai)
#pragma unroll
            for (int m = 0; m < 4; ++m) { bf16_t* rowp = base + (size_t)(row0 + ai * HALF + m * 16) * ldc + col0;
#pragma unroll
                for (int bj = 0; bj < 2; ++bj) { f32x4 v0 = acc[ai][bj][m][0] + bv[bj][0], v1 = acc[ai][bj][m][1] + bv[bj][1];

                    v0 = v0 * sc; v1 = v1 * sc; u32x4 w; w.x = cvt_pk_bf16(v0[0], v0[1]); w.y = cvt_pk_bf16(v0[2], v0[3]); w.z = cvt_pk_bf16(v1[0], v1[1]); w.w = cvt_pk_bf16(v1[2], v1[3]);
                    *(u32x4*)(rowp + bj * HALF) = w; } }
    }
};


struct EpiF32 {
    static constexpr bool PERM = false, AFTER_DRAIN = false;
    float* C; int ldc; const float* bias;
    __device__ __forceinline__ void operator()(const f32x4 (&acc)[2][2][4][2], const Unit& u, int wr, int wc, int fr, int fq) const {
        const int row0 = u.pm * BM + wr * 64 + fr, col0 = u.pn * BM + wc * 32 + 4 * fq;
        f32x4 bv[2][2];
#pragma unroll
        for (int bj = 0; bj < 2; ++bj)
#pragma unroll
            for (int n = 0; n < 2; ++n) bv[bj][n] = bias ? *(const f32x4*)(bias + col0 + bj * HALF + n * 16) : (f32x4){0.f, 0.f, 0.f, 0.f};
#pragma unroll
        for (int ai = 0; ai < 2; ++ai)
#pragma unroll
            for (int m = 0; m < 4; ++m) { float* rowp = C + (size_t)(row0 + ai * HALF + m * 16) * ldc + col0;
#pragma unroll
                for (int bj = 0; bj < 2; ++bj)
#pragma unroll
                    for (int n = 0; n < 2; ++n) *(f32x4*)(rowp + bj * HALF + n * 16) = acc[ai][bj][m][n] + bv[bj][n]; }
    }
};
struct EpiSwiGLU {
    static constexpr bool PERM = true, AFTER_DRAIN = false;
    bf16_t* O; int ldc;
    __device__ __forceinline__ static float sw(float g, float u) { return g * u * __builtin_amdgcn_rcpf(1.0f + __builtin_amdgcn_exp2f(-1.44269504f * g)); }
    __device__ __forceinline__ void operator()(const f32x4 (&acc)[2][2][4][2], const Unit& u, int wr, int wc, int fr, int fq) const {
        const int row0 = u.pm * BM + wr * 64 + fr, col0 = u.pn * HALF + wc * 32 + 8 * fq;
#pragma unroll
        for (int ai = 0; ai < 2; ++ai)
#pragma unroll
            for (int m = 0; m < 4; ++m) { bf16_t* rowp = O + (size_t)(row0 + ai * HALF + m * 16) * ldc + col0;
                const f32x4 g0 = acc[ai][0][m][0], g1 = acc[ai][0][m][1], u0 = acc[ai][1][m][0], u1 = acc[ai][1][m][1];
                u32x4 w; w.x = cvt_pk_bf16(sw(g0[0], u0[0]), sw(g0[1], u0[1])); w.y = cvt_pk_bf16(sw(g0[2], u0[2]), sw(g0[3], u0[3]));
                w.z = cvt_pk_bf16(sw(g1[0], u1[0]), sw(g1[1], u1[1])); w.w = cvt_pk_bf16(sw(g1[2], u1[2]), sw(g1[3], u1[3]));
                *(u32x4*)rowp = w; }
    }
};
template <class Epi, class Sched, bool ALIGN_EPI = false, bool SP2 = false>
__device__ __forceinline__ void gemm_phase(PG8_LAS unsigned char* lds, const Gemm g, const Sched& S, const Epi& E) {
    int tid_ = threadIdx.x; asm volatile("" : "+v"(tid_)); const int tid = tid_, wid = __builtin_amdgcn_readfirstlane(tid >> 6), lane = tid & 63, wr = wid >> 2, wc = wid & 3, fr = lane & 15, fq = lane >> 4;
    const int K = g.K, nt = K / BK;
    unsigned voffA[2], voffB[2];
#pragma unroll
    for (int i = 0; i < 2; ++i) { int R, C; stage_rc(tid * 16 + i * 8192, R, C); const int Rb = Epi::PERM ? ((R & ~31) + perm32(R & 31)) : R;
        voffA[i] = (unsigned)(R * g.lda + C) * 2u; voffB[i] = (unsigned)(Rb * g.ldb + C) * 2u; }
    const size_t kstep = (size_t)(BK * 2);
    const size_t hstepA = (size_t)HALF * g.lda * 2, hstepB = (size_t)HALF * g.ldb * 2;
    const size_t tstepA = 2 * hstepA, tstepB = 2 * hstepB;
    const unsigned ldsw = (unsigned)wid * 1024u;
    const int aoff = lds_byte(wr * 64 + fr, fq * 8), boff = lds_byte(wc * 32 + fr, fq * 8);
#define PG8_SA(b, h) (((b) * 2 + (h)) * HTB)
#define PG8_SB(b, h) ((4 + (b) * 2 + (h)) * HTB)
#define PG8_STAGE(bufoff, gbase, voff) do { _Pragma("unroll") for (int _i = 0; _i < 2; ++_i) \
        __builtin_amdgcn_global_load_lds((const unsigned*)((const char*)(gbase) + (voff)[_i]), (PG8_LAS unsigned*)(lds + (bufoff) + ldsw + _i * 8192), 16, 0, 0); } while (0)
#define PG8_LDA(dst, b, h) do { _Pragma("unroll") for (int m = 0; m < 4; ++m) _Pragma("unroll") for (int k = 0; k < 2; ++k) dst[m][k] = *(const PG8_LAS bf16x8*)(lds + PG8_SA(b, h) + aoff + m * 2048 + k * 1024); } while (0)
#define PG8_LDB(dst, b, h) do { _Pragma("unroll") for (int n = 0; n < 2; ++n) _Pragma("unroll") for (int k = 0; k < 2; ++k) dst[n][k] = *(const PG8_LAS bf16x8*)(lds + PG8_SB(b, h) + boff + n * 2048 + k * 1024); } while (0)
#define PG8_MMA(ai, bj, At, Bt) do { __builtin_amdgcn_s_setprio(1); _Pragma("unroll") for (int m = 0; m < 4; ++m) _Pragma("unroll") for (int n = 0; n < 2; ++n) _Pragma("unroll") for (int k = 0; k < 2; ++k) \
        acc[ai][bj][m][n] = __builtin_amdgcn_mfma_f32_16x16x32_bf16(Bt[n][k], At[m][k], acc[ai][bj][m][n], 0, 0, 0); __builtin_amdgcn_s_setprio(0); } while (0)
#define PG8_WAIT_V(n) asm volatile("s_waitcnt vmcnt(" #n ")" ::: "memory")
#define PG8_WAIT_L(n) asm volatile("s_waitcnt lgkmcnt(" #n ")" ::: "memory")
#define PG8_BAR __builtin_amdgcn_s_barrier()
#define PG8_SCHED __builtin_amdgcn_sched_barrier(0)
    Unit cur, nxt; int ui = 0;
    if (!S.next(0, cur)) return;
    f32x4 acc[2][2][4][2];
#pragma unroll
    for (int a = 0; a < 2; ++a)
#pragma unroll
        for (int b = 0; b < 2; ++b)
#pragma unroll
            for (int m = 0; m < 4; ++m)
#pragma unroll
                for (int n = 0; n < 2; ++n) acc[a][b][m][n] = (f32x4){0.f, 0.f, 0.f, 0.f};
    bf16x8 At[4][2], B0[2][2], B1[2][2];
    const char* cA = (const char*)g.A + (size_t)cur.pm * tstepA + (size_t)((cur.pn & g.amask) * 512); const char* cB = (const char*)g.Bt + (size_t)cur.pn * tstepB;
    S.a_ready(cur);
    if constexpr (SP2) {
        PG8_STAGE(PG8_SB(0, 0), cB, voffB); PG8_STAGE(PG8_SB(0, 1), cB + hstepB, voffB); PG8_STAGE(PG8_SA(0, 0), cA, voffA); PG8_STAGE(PG8_SA(0, 1), cA + hstepA, voffA);
        if (wr == 1) PG8_BAR;
        PG8_WAIT_V(2); PG8_BAR;
        PG8_STAGE(PG8_SB(1, 0), cB + kstep, voffB); PG8_STAGE(PG8_SA(1, 0), cA + kstep, voffA); PG8_STAGE(PG8_SB(1, 1), cB + hstepB + kstep, voffB);
        PG8_WAIT_V(6); PG8_BAR;
    } else {
        PG8_STAGE(PG8_SB(0, 0), cB, voffB); PG8_STAGE(PG8_SA(0, 0), cA, voffA); PG8_STAGE(PG8_SB(0, 1), cB + hstepB, voffB); PG8_STAGE(PG8_SA(0, 1), cA + hstepA, voffA);
        if (wr == 1) PG8_BAR;
        PG8_WAIT_V(4); PG8_BAR;
        PG8_STAGE(PG8_SB(1, 0), cB + kstep, voffB); PG8_STAGE(PG8_SA(1, 0), cA + kstep, voffA); PG8_STAGE(PG8_SB(1, 1), cB + hstepB + kstep, voffB);
        PG8_WAIT_V(6); PG8_BAR;
    }
    for (;;) {
        const bool has_next = S.next(ui + 1, nxt);
        const char* nA = has_next ? (const char*)g.A + (size_t)nxt.pm * tstepA + (size_t)((nxt.pn & g.amask) * 512) : cA; const char* nB = has_next ? (const char*)g.Bt + (size_t)nxt.pn * tstepB : cB;
        for (int t = 0; t < nt; t += 2) {
            const bool last = (t == nt - 2);
            const char* a1 = cA + (size_t)(t + 1) * kstep;
            const char* a2 = last ? nA : cA + (size_t)(t + 2) * kstep; const char* b2 = last ? nB : cB + (size_t)(t + 2) * kstep;
            const char* a3 = a2 + kstep; const char* b3 = b2 + kstep;
            if (last && has_next) S.a_ready(nxt);
            if constexpr (SP2) {
            PG8_LDB(B0, 0, 0); PG8_LDB(B1, 0, 1); PG8_SCHED; PG8_LDA(At, 0, 0); PG8_STAGE(PG8_SA(1, 1), a1 + hstepA, voffA);
            PG8_WAIT_V(8); PG8_WAIT_L(0); PG8_BAR; PG8_MMA(0, 0, At, B0); PG8_MMA(0, 1, At, B1); PG8_BAR; PG8_SCHED;
            PG8_LDA(At, 0, 1); PG8_STAGE(PG8_SB(0, 0), b2, voffB); PG8_STAGE(PG8_SB(0, 1), b2 + hstepB, voffB); PG8_STAGE(PG8_SA(0, 0), a2, voffA);
            PG8_WAIT_V(8); PG8_WAIT_L(0); PG8_BAR; PG8_MMA(1, 0, At, B0); PG8_MMA(1, 1, At, B1); PG8_BAR; PG8_SCHED;
            PG8_LDB(B0, 1, 0); PG8_LDB(B1, 1, 1); PG8_SCHED; PG8_LDA(At, 1, 0); PG8_STAGE(PG8_SA(0, 1), a2 + hstepA, voffA);
            PG8_WAIT_V(8); PG8_WAIT_L(0); PG8_BAR; PG8_MMA(0, 0, At, B0); PG8_MMA(0, 1, At, B1); PG8_BAR; PG8_SCHED;
            PG8_LDA(At, 1, 1); PG8_STAGE(PG8_SB(1, 0), b3, voffB); PG8_STAGE(PG8_SB(1, 1), b3 + hstepB, voffB); PG8_STAGE(PG8_SA(1, 0), a3, voffA);
            PG8_WAIT_V(8); PG8_WAIT_L(0); PG8_BAR; PG8_MMA(1, 0, At, B0); PG8_MMA(1, 1, At, B1); PG8_BAR; PG8_SCHED;
            } else {
            PG8_LDB(B0, 0, 0); PG8_SCHED; PG8_LDA(At, 0, 0); PG8_STAGE(PG8_SA(1, 1), a1 + hstepA, voffA);
            PG8_WAIT_L(8); PG8_BAR; PG8_WAIT_L(0); PG8_MMA(0, 0, At, B0); PG8_BAR; PG8_SCHED;
            PG8_LDB(B1, 0, 1); PG8_STAGE(PG8_SB(0, 0), b2, voffB);
            PG8_BAR; PG8_WAIT_L(0); PG8_MMA(0, 1, At, B1); PG8_BAR;
            PG8_LDA(At, 0, 1); PG8_STAGE(PG8_SA(0, 0), a2, voffA);
            PG8_BAR; PG8_WAIT_L(0); PG8_MMA(1, 0, At, B0); PG8_BAR; PG8_SCHED;
            PG8_STAGE(PG8_SB(0, 1), b2 + hstepB, voffB);
            PG8_WAIT_V(6); PG8_BAR; PG8_MMA(1, 1, At, B1); PG8_BAR;
            PG8_LDB(B0, 1, 0); PG8_SCHED; PG8_LDA(At, 1, 0); PG8_STAGE(PG8_SA(0, 1), a2 + hstepA, voffA);
            PG8_WAIT_L(8); PG8_BAR; PG8_WAIT_L(0); PG8_MMA(0, 0, At, B0); PG8_BAR; PG8_SCHED;
            PG8_LDB(B1, 1, 1); PG8_STAGE(PG8_SB(1, 0), b3, voffB);
            PG8_BAR; PG8_WAIT_L(0); PG8_MMA(0, 1, At, B1); PG8_BAR;
            PG8_LDA(At, 1, 1); PG8_STAGE(PG8_SA(1, 0), a3, voffA);
            PG8_BAR; PG8_WAIT_L(0); PG8_MMA(1, 0, At, B0); PG8_BAR; PG8_SCHED;
            PG8_STAGE(PG8_SB(1, 1), b3 + hstepB, voffB);
            PG8_WAIT_V(6); PG8_BAR; PG8_MMA(1, 1, At, B1); PG8_BAR;
            }
        }
        if constexpr (ALIGN_EPI) { if (wr == 0) PG8_BAR; }
        if constexpr (!Epi::AFTER_DRAIN) { E(acc, cur, wr, wc, fr, fq); S.done(cur); }
        if (!has_next) break;
#pragma unroll
        for (int a = 0; a < 2; ++a)
#pragma unroll
            for (int b = 0; b < 2; ++b)
#pragma unroll
                for (int m = 0; m < 4; ++m)
#pragma unroll
                    for (int n = 0; n < 2; ++n) acc[a][b][m][n] = (f32x4){0.f, 0.f, 0.f, 0.f};
        cur = nxt; cA = nA; cB = nB; ++ui;
        if constexpr (ALIGN_EPI) { if (wr == 1) PG8_BAR; }
    }
    PG8_WAIT_V(0);
    if constexpr (!ALIGN_EPI) { if (wr == 0) PG8_BAR; }
    PG8_BAR;
    if constexpr (Epi::AFTER_DRAIN) { E.fused(acc, cur, wr, wc, fr, fq, lds, wid, lane); S.done(cur); }
#undef PG8_SA
#undef PG8_SB
#undef PG8_STAGE
#undef PG8_LDA
#undef PG8_LDB
#undef PG8_MMA
#undef PG8_WAIT_V
#undef PG8_WAIT_L
#undef PG8_BAR
#undef PG8_SCHED
}
}

constexpr int DM = 2048, NPB = 4, SEQ = 2048, NDB = 128, DSEQ = 8;
constexpr int MP = NPB * SEQ, MS = NDB * DSEQ, M = MP + MS, NSEQ = NPB + NDB;
constexpr int DINE = 7424, DINO = 6144, DRP = 3328, DFF = 5632;
constexpr float RMS_EPS = 1e-6f, GN_EPS = 64e-5f;
constexpr int NWAVES = 8, NTHR = 512;

constexpr size_t SZ_HGRN = 8 * 128 * 128, SZ_RWKV = 16 * 64 * 64, SZ_RET = 4 * 256 * 256, SZ_CONV = 3 * 1024;
constexpr size_t O_HGRN_P = (size_t)M * DM;
constexpr size_t O_HGRN_S = O_HGRN_P + 2 * NPB * SZ_HGRN;
constexpr size_t O_RWKV_P = O_HGRN_S + 2 * NDB * SZ_HGRN;
constexpr size_t O_RWKV_S = O_RWKV_P + 2 * NPB * SZ_RWKV;
constexpr size_t O_SHIFT_P = O_RWKV_S + 2 * NDB * SZ_RWKV;
constexpr size_t O_SHIFT_S = O_SHIFT_P + 2 * NPB * DRP;
constexpr size_t O_RET_P = O_SHIFT_S + 2 * NDB * DRP;
constexpr size_t O_RET_S = O_RET_P + 2 * NPB * SZ_RET;
constexpr size_t O_CONV_P = O_RET_S + 2 * NDB * SZ_RET;
constexpr size_t O_CONV_S = O_CONV_P + 2 * NPB * SZ_CONV;
constexpr size_t O_H_P = O_CONV_S + 2 * NDB * SZ_CONV;
constexpr size_t O_H_S = O_H_P + 2 * NPB * 1024;
constexpr size_t O_END = O_H_S + 2 * NDB * 1024;
static_assert(O_END == 141944832ull, "output size");

constexpr size_t WS_CTL = 0, CTL_BYTES = 1u << 20;
constexpr size_t WS_WIE = CTL_BYTES;
constexpr size_t WS_WOE = WS_WIE + 2ull * DINE * DM * 2;
constexpr size_t WS_WIO = WS_WOE + 2ull * DM * DM * 2;
constexpr size_t WS_WOO = WS_WIO + 2ull * DINO * DM * 2;
constexpr size_t WS_WFI = WS_WOO + 2ull * DM * DM * 2;
constexpr size_t WS_WFO = WS_WFI + 4ull * 2 * DFF * DM * 2;
constexpr size_t WS_WLR = WS_WFO + 4ull * DM * DFF * 2;
constexpr size_t WS_WGT = WS_WLR + 2ull * 3072 * 256 * 2;
constexpr size_t WS_BLR = WS_WGT + 2ull * 2048 * 256 * 2;
constexpr size_t WS_BGT = WS_BLR + 2ull * 3072 * 4;
constexpr size_t WS_ROT = WS_BGT + 2ull * 2048 * 4;
constexpr size_t WS_HN = WS_ROT + 2056ull * 128 * 8;
constexpr size_t WS_Z = WS_HN + (size_t)M * DM * 2;
constexpr size_t WS_O = WS_Z + (size_t)M * DINE * 2;
constexpr size_t WS_MIX = WS_O + (size_t)M * DM * 2;
constexpr size_t WS_ACT = WS_MIX + (size_t)M * DM * 4;
constexpr size_t WS_SA = WS_ACT + (size_t)M * DFF * 2;
constexpr size_t WS_SG = WS_SA + (size_t)M * 1024 * 2;
constexpr size_t WS_ORAW = WS_SG + (size_t)M * 3072 * 4;
constexpr size_t WS_YRAW = WS_ORAW + (size_t)M * 1024 * 4;
constexpr size_t WS_RK = WS_YRAW + (size_t)M * 1024 * 4;
constexpr size_t WS_END = WS_RK + (size_t)M * 16 * 4;
static_assert(WS_HN % 256 == 0 && WS_Z % 256 == 0 && WS_SG % 256 == 0, "alignment");
constexpr int CW_BAR = 4096;

constexpr int RING_OFF = 0, RING_BYTES = 131072;
constexpr int LDSCTL_OFF = RING_BYTES, MISC_OFF = LDSCTL_OFF + 320;
constexpr int LDS_BYTES = 147456;

#define GAS __attribute__((address_space(1)))
#define LAS __attribute__((address_space(3)))
typedef unsigned short bf16;
typedef unsigned v4u __attribute__((ext_vector_type(4)));
typedef unsigned v2u __attribute__((ext_vector_type(2)));
typedef float f32x4 __attribute__((ext_vector_type(4)));
typedef float f32x2 __attribute__((ext_vector_type(2)));
#define LDS_WAIT() asm volatile("s_waitcnt lgkmcnt(0)" ::: "memory")
__device__ __forceinline__ unsigned f2bf(float f) { unsigned u = __builtin_bit_cast(unsigned, f); return (u + 0x7fffu + ((u >> 16) & 1u)) >> 16; }
__device__ __forceinline__ unsigned pk2(float lo, float hi) { return f2bf(lo) | (f2bf(hi) << 16); }
__device__ __forceinline__ float bf2f(bf16 b) { return __uint_as_float((unsigned)b << 16); }
__device__ __forceinline__ float bflo(unsigned w) { return __uint_as_float(w << 16); }
__device__ __forceinline__ float bfhi(unsigned w) { return __uint_as_float(w & 0xffff0000u); }
__device__ __forceinline__ void unpack8(const v4u w, float (&f)[8]) { f[0] = bflo(w.x); f[1] = bfhi(w.x); f[2] = bflo(w.y); f[3] = bfhi(w.y); f[4] = bflo(w.z); f[5] = bfhi(w.z); f[6] = bflo(w.w); f[7] = bfhi(w.w); }
__device__ __forceinline__ v4u pack8(const float (&f)[8]) { v4u w; w.x = pk2(f[0], f[1]); w.y = pk2(f[2], f[3]); w.z = pk2(f[4], f[5]); w.w = pk2(f[6], f[7]); return w; }
__device__ __forceinline__ float sigm(float x) { return 1.0f / (1.0f + __expf(-x)); }
__device__ __forceinline__ float siluf(float x) { return x * sigm(x); }
template <int CTRL> __device__ __forceinline__ float dpp(float x) { return __builtin_bit_cast(float, __builtin_amdgcn_update_dpp(0, __builtin_bit_cast(int, x), CTRL, 0xF, 0xF, true)); }
__device__ __forceinline__ float quad_sum(float x) { x += dpp<0xB1>(x); x += dpp<0x4E>(x); return x; }
__device__ __forceinline__ float oct_sum(float x) { x = quad_sum(x); x += dpp<0x141>(x); return x; }
__device__ __forceinline__ float row16_sum(float x) { x = oct_sum(x); x += dpp<0x140>(x); return x; }
__device__ __forceinline__ float wave_sum(float v) {
#pragma unroll
    for (int o = 1; o < 64; o <<= 1) v += __shfl_xor(v, o);
    return v;
}
__device__ __forceinline__ int seq_T(int s) { return s < NPB ? SEQ : DSEQ; }
__device__ __forceinline__ int seq_row0(int s) { return s < NPB ? s * SEQ : MP + (s - NPB) * DSEQ; }
__device__ __forceinline__ void row_ts(int row, int& t, int& s) { if (row < MP) { t = row & (SEQ - 1); s = row >> 11; } else { const int r2 = row - MP; t = r2 & (DSEQ - 1); s = NPB + (r2 >> 3); } }
__device__ __forceinline__ float* st_out_ptr(float* out, size_t base_p, size_t base_s, size_t per, int j, int s) {
    return s < NPB ? out + base_p + ((size_t)j * NPB + s) * per : out + base_s + ((size_t)j * NDB + (s - NPB)) * per; }

#define XB_TMO      128
#define XB_XCNT(j)  (256  + 64 * (j))
#define XB_XSUB(j)  (1280 + 64 * (j))
#define XB_XGEN(j)  (2304 + 64 * (j))
#define XB_TOP      3328
#define XB_TOPGEN   3392
#define XCD_BAR_WORDS 3456
#define XB_SPIN_CAP (1u << 18)

__device__ __forceinline__ unsigned xb_ld(unsigned* p)              { return __hip_atomic_load(p, __ATOMIC_RELAXED, __HIP_MEMORY_SCOPE_AGENT); }
__device__ __forceinline__ unsigned xb_add(unsigned* p, unsigned v) { return __hip_atomic_fetch_add(p, v, __ATOMIC_RELAXED, __HIP_MEMORY_SCOPE_AGENT); }
__device__ __forceinline__ unsigned xb_xcc_id() { return (unsigned)__builtin_amdgcn_s_getreg((3 << 11) | 20) & 0xFu; }
#define XB_SPIN(cond, bar) do { unsigned _sp = 0; while (cond) { __builtin_amdgcn_s_sleep(1); \
    if ((++_sp & 255u) == 0u) { if (xb_ld(&(bar)[XB_TMO])) break; if (_sp > XB_SPIN_CAP) { atomicAdd(&(bar)[XB_TMO], 1u); break; } } } } while (0)

struct XcdBarrier {
    unsigned* bar; unsigned x;
    volatile LAS unsigned* st;
};

__device__ __forceinline__ XcdBarrier xcd_barrier_post(unsigned* bar, volatile LAS unsigned* st) {
    XcdBarrier b; b.bar = bar; b.x = xb_xcc_id(); b.st = st;
    if (threadIdx.x == 0) (void)xb_add(&bar[XB_XCNT(b.x)], 1u);
    return b;
}
__device__ __forceinline__ void xcd_barrier_complete(unsigned* bar, unsigned x, unsigned& nloc, unsigned& nx) {
    const unsigned G = gridDim.x * gridDim.y * gridDim.z;
    unsigned sum, cnt, mine, sp = 0u;
    for (;;) {
        sum = 0u; cnt = 0u; mine = 0u;
#pragma unroll
        for (unsigned j = 0; j < 16; ++j) { const unsigned c = xb_ld(&bar[XB_XCNT(j)]); sum += c; cnt += (c > 0u) ? 1u : 0u; mine = (j == x) ? c : mine; }
        if (sum == G) break;
        __builtin_amdgcn_s_sleep(1);
        if ((++sp & 255u) == 0u) { if (xb_ld(&bar[XB_TMO])) break; if (sp > XB_SPIN_CAP) { atomicAdd(&bar[XB_TMO], 1u); break; } }
    }
    nloc = mine > 0u ? mine : 1u; nx = cnt > 0u ? cnt : 1u;
}

__device__ __forceinline__ void xcd_barrier(const XcdBarrier& b) {
    asm volatile("s_waitcnt vmcnt(0)" ::: "memory");
    __syncthreads();
    if (threadIdx.x == 0) {
        unsigned* bar = b.bar;
        __builtin_amdgcn_s_waitcnt(0);
        unsigned nloc = b.st[0], nx = b.st[1];
        if (nloc == 0u) { xcd_barrier_complete(bar, b.x, nloc, nx); b.st[0] = nloc; b.st[1] = nx; }
        const unsigned old = xb_add(&bar[XB_XSUB(b.x)], 1u);
        const unsigned gen = old / nloc;
        if (old + 1u == (gen + 1u) * nloc) {
            __builtin_amdgcn_fence(__ATOMIC_RELEASE, "agent");
            asm volatile("s_waitcnt vmcnt(0)" ::: "memory");
            const unsigned og = xb_add(&bar[XB_TOP], 1u);
            const unsigned tg = og / nx;
            if (og + 1u == (tg + 1u) * nx) xb_add(&bar[XB_TOPGEN], 1u);
            else XB_SPIN(xb_ld(&bar[XB_TOPGEN]) == tg, bar);
            __builtin_amdgcn_fence(__ATOMIC_ACQUIRE, "agent");
            xb_add(&bar[XB_XGEN(b.x)], 1u);
            asm volatile("s_waitcnt vmcnt(0)" ::: "memory");
        } else {
            XB_SPIN(xb_ld(&bar[XB_XGEN(b.x)]) == gen, bar);
            __builtin_amdgcn_fence(__ATOMIC_ACQUIRE, "agent");
            asm volatile("s_waitcnt vmcnt(0)" ::: "memory");
        }
    }
    __syncthreads();
}


__device__ __forceinline__ void p0_transpose_item(const float* W, int K, int N, bf16* WT, int mode, LAS unsigned char* scr, int item, int lane) {
    const int nblk = N / 64, kb = item / nblk, nb = item - kb * nblk, k0 = 64 * kb, n0 = 64 * nb;
    const GAS float* src = (const GAS float*)W + (size_t)(k0 + (lane >> 4) * 16) * N + n0 + (lane & 15) * 4;
    f32x4 v[16];
#pragma unroll
    for (int i = 0; i < 16; ++i) v[i] = *(const GAS f32x4*)(src + (size_t)i * N);
#pragma unroll
    for (int e = 0; e < 4; ++e) {
        v4u a, b; a.x = pk2(v[0][e], v[1][e]); a.y = pk2(v[2][e], v[3][e]); a.z = pk2(v[4][e], v[5][e]); a.w = pk2(v[6][e], v[7][e]);
        b.x = pk2(v[8][e], v[9][e]); b.y = pk2(v[10][e], v[11][e]); b.z = pk2(v[12][e], v[13][e]); b.w = pk2(v[14][e], v[15][e]);
        LAS unsigned char* p = scr + ((lane & 15) * 4 + e) * 144 + (lane >> 4) * 32;
        *(LAS v4u*)p = a; *(LAS v4u*)(p + 16) = b;
    }
    LDS_WAIT();
    int nrow0 = n0;
    if (mode == 1) { const int up = n0 >= DFF ? 1 : 0, c = n0 - up * DFF; nrow0 = (c >> 7) * 256 + (c & 127) + up * 128; }
#pragma unroll
    for (int jj = 0; jj < 8; ++jj) { const int n = (lane >> 3) + 8 * jj;
        const v4u o = *(const LAS v4u*)(scr + n * 144 + (lane & 7) * 16);
        *(GAS v4u*)((GAS bf16*)WT + (size_t)(nrow0 + n) * K + k0 + (lane & 7) * 8) = o; }
    LDS_WAIT();
}

template <bool HAS_MIX, bool HAS_HN>
__device__ __forceinline__ void norm_row(const float* xin, const float* mix, float* xout, const float* wpost, const float* wpre, bf16* hn, int lane) {
    const GAS f32x4* xr = (const GAS f32x4*)xin + lane;
    f32x4 x[8];
#pragma unroll
    for (int jj = 0; jj < 8; ++jj) x[jj] = xr[64 * jj];
    if (HAS_MIX) {
        const GAS f32x4* mr = (const GAS f32x4*)mix + lane; const GAS f32x4* wp = (const GAS f32x4*)wpost + lane;
        f32x4 m[8]; float s = 0.f;
#pragma unroll
        for (int jj = 0; jj < 8; ++jj) { m[jj] = mr[64 * jj]; s += (m[jj].x * m[jj].x + m[jj].y * m[jj].y) + (m[jj].z * m[jj].z + m[jj].w * m[jj].w); }
        const float rs = rsqrtf(wave_sum(s) * (1.0f / DM) + RMS_EPS);
#pragma unroll
        for (int jj = 0; jj < 8; ++jj) { const f32x4 w = wp[64 * jj]; x[jj] = x[jj] + m[jj] * rs * w; }
    }
    GAS f32x4* xo = (GAS f32x4*)xout + lane;
#pragma unroll
    for (int jj = 0; jj < 8; ++jj) xo[64 * jj] = x[jj];
    if (HAS_HN) {
        float s = 0.f;
#pragma unroll
        for (int jj = 0; jj < 8; ++jj) s += (x[jj].x * x[jj].x + x[jj].y * x[jj].y) + (x[jj].z * x[jj].z + x[jj].w * x[jj].w);
        const float rs = rsqrtf(wave_sum(s) * (1.0f / DM) + RMS_EPS);
        const GAS f32x4* wq = (const GAS f32x4*)wpre + lane; GAS v2u* ho = (GAS v2u*)hn + lane;
#pragma unroll
        for (int jj = 0; jj < 8; ++jj) { const f32x4 w = wq[64 * jj]; const f32x4 y = x[jj] * rs * w; v2u o; o.x = pk2(y.x, y.y); o.y = pk2(y.z, y.w); ho[64 * jj] = o; }
    }
}

template <int VPL>
__device__ __forceinline__ void hgrn_unit(LAS float* L, const bf16* Z, int j, int s, int h, int vs, const float* st_in, float* st_out, float* ORAW, const float* lbraw, int tid) {
    constexpr int TB = VPL == 1 ? 32 : 8, NV = 16 * VPL;
    LAS float* Q = L; LAS float* K = Q + TB * 128; LAS float* F = K + TB * 128; LAS float* V = F + TB * 128; LAS float* OP = V + TB * NV;
    const int T = seq_T(s), row0 = seq_row0(s);
    const int w = tid >> 6, lane = tid & 63, vl = lane >> 2, dl = lane & 3, dk0 = 16 * w + 4 * dl;
    const int vcol0 = vs * NV + vl * VPL;
    float S[VPL][4];
#pragma unroll
    for (int c = 0; c < VPL; ++c)
#pragma unroll
        for (int e = 0; e < 4; ++e) S[c][e] = st_in ? st_in[(size_t)(dk0 + e) * 128 + vcol0 + c] : 0.f;
    const int ptt = tid >> 4, pd8 = (tid & 15) * 8;
    float lb[8];
#pragma unroll
    for (int e = 0; e < 8; ++e) lb[e] = (j == 0) ? 0.f : sigm(lbraw[1024 + h * 128 + pd8 + e] - lbraw[h * 128 + pd8 + e]);
    for (int t0 = 0; t0 < T; t0 += TB) {
        __syncthreads();
        if (ptt < TB) {
            const bf16* zr = Z + (size_t)(row0 + t0 + ptt) * DINE + h * 128 + pd8;
            float zq[8], zf[8]; unpack8(*(const GAS v4u*)zr, zq); unpack8(*(const GAS v4u*)(zr + 1024), zf);
            float q[8], k[8], f[8];
#pragma unroll
            for (int e = 0; e < 8; ++e) { q[e] = siluf(zq[e]); const float ex = __expf(-zf[e]); const float sg = 1.0f / (1.0f + ex); f[e] = lb[e] + (1.0f - lb[e]) * sg; k[e] = (1.0f - lb[e]) * (ex < 1e30f ? ex * sg : 1.0f); }
            LAS f32x4* qd = (LAS f32x4*)(Q + ptt * 128 + pd8); LAS f32x4* kd = (LAS f32x4*)(K + ptt * 128 + pd8); LAS f32x4* fd = (LAS f32x4*)(F + ptt * 128 + pd8);
            qd[0] = (f32x4){q[0], q[1], q[2], q[3]}; qd[1] = (f32x4){q[4], q[5], q[6], q[7]};
            kd[0] = (f32x4){k[0], k[1], k[2], k[3]}; kd[1] = (f32x4){k[4], k[5], k[6], k[7]};
            fd[0] = (f32x4){f[0], f[1], f[2], f[3]}; fd[1] = (f32x4){f[4], f[5], f[6], f[7]};
        }
        for (int idx = tid; idx < TB * NV; idx += NTHR) { const int tt = idx / NV, c = idx - tt * NV; V[idx] = bf2f(Z[(size_t)(row0 + t0 + tt) * DINE + 2048 + h * 128 + vs * NV + c]); }
        __syncthreads();
#pragma unroll 2
        for (int tt = 0; tt < TB; ++tt) {
            const f32x4 q4 = *(const LAS f32x4*)(Q + tt * 128 + dk0), k4 = *(const LAS f32x4*)(K + tt * 128 + dk0), f4 = *(const LAS f32x4*)(F + tt * 128 + dk0);
#pragma unroll
            for (int c = 0; c < VPL; ++c) {
                const float v = V[tt * NV + vl * VPL + c]; float o = 0.f;
#pragma unroll
                for (int e = 0; e < 4; ++e) { S[c][e] = f4[e] * S[c][e] + k4[e] * v; o += S[c][e] * q4[e]; }
                o = quad_sum(o);
                if (dl == 0) OP[(w * TB + tt) * NV + vl * VPL + c] = o;
            }
        }
        __syncthreads();
        for (int idx = tid; idx < TB * NV; idx += NTHR) { const int tt = idx / NV, c = idx - tt * NV; float o = 0.f;
#pragma unroll
            for (int ww = 0; ww < 8; ++ww) o += OP[(ww * TB + tt) * NV + c];
            ORAW[(size_t)(row0 + t0 + tt) * 1024 + h * 128 + vs * NV + c] = o; }
    }
#pragma unroll
    for (int c = 0; c < VPL; ++c)
#pragma unroll
        for (int e = 0; e < 4; ++e) st_out[(size_t)(dk0 + e) * 128 + vcol0 + c] = S[c][e];
}

struct RwkvP { const float *mu, *kk, *ka, *rk; };
template <int RPL>
__device__ __forceinline__ void rwkv_unit(LAS float* L, const bf16* Z, const float* SG, const RwkvP P, int s, int h, int rbase, bool write_rk, const float* st_shift, const float* st_in, float* st_out, float* YRAW, float* RK, int tid) {
    constexpr int TB = RPL == 1 ? 32 : 8, NR = 16 * RPL;
    LAS float* Wd = L; LAS float* KK = Wd + TB * 64; LAS float* KA = KK + TB * 64; LAS float* KB = KA + TB * 64; LAS float* R = KB + TB * 64; LAS float* Vv = R + TB * 64; LAS float* Yo = Vv + TB * NR;
    const int T = seq_T(s), row0 = seq_row0(s);
    const int w = tid >> 6, lane = tid & 63, il = tid >> 4, jp = tid & 15;
    float S[RPL][4];
    if (tid < 256) {
#pragma unroll
        for (int rr = 0; rr < RPL; ++rr) { f32x4 v = (f32x4){0.f, 0.f, 0.f, 0.f}; if (st_in) v = *(const GAS f32x4*)(st_in + (size_t)(rbase + il + 16 * rr) * 64 + 4 * jp);
            S[rr][0] = v.x; S[rr][1] = v.y; S[rr][2] = v.z; S[rr][3] = v.w; }
    }
    const int colr = h * 64 + lane;
    const float mu_r = P.mu[colr], mu_k = P.mu[1024 + colr], mu_v = P.mu[2048 + colr], c_kk = P.kk[colr], c_ka = P.ka[colr], c_rk = P.rk[colr];
    for (int t0 = 0; t0 < T; t0 += TB) {
        __syncthreads();
        for (int tt = w; tt < TB; tt += 8) {
            const int t = t0 + tt, row = row0 + t;
            const bf16* zb = Z + (size_t)row * DINE + 4096 + colr;
            const float r0 = bf2f(zb[0]), k0 = bf2f(zb[1024]), v0 = bf2f(zb[2048]);
            float pr = 0.f, pk = 0.f, pv = 0.f;
            if (t > 0) { pr = bf2f(zb[-DINE]); pk = bf2f(zb[1024 - DINE]); pv = bf2f(zb[2048 - DINE]); }
            else if (st_shift) { pr = st_shift[colr]; pk = st_shift[1024 + colr]; pv = st_shift[2048 + colr]; }
            const float r = r0 + (pr - r0) * mu_r, kb = k0 + (pk - k0) * mu_k, v = v0 + (pv - v0) * mu_v;
            const float wpre = SG[(size_t)row * 3072 + colr], apre = SG[(size_t)row * 3072 + 1024 + colr];
            const float wdec = __expf(-0.6065306597f * sigm(wpre)), a = sigm(apre);
            float kk = kb * c_kk; const float n2 = wave_sum(kk * kk); kk = kk / fmaxf(sqrtf(n2), 1e-12f);
            const float kbm = kb * (1.0f + (a - 1.0f) * c_ka);
            const float rk = wave_sum(r * kbm * c_rk);
            Wd[tt * 64 + lane] = wdec; KK[tt * 64 + lane] = kk; KA[tt * 64 + lane] = kk * a; KB[tt * 64 + lane] = kbm; R[tt * 64 + lane] = r;
            if (lane >= rbase && lane < rbase + NR) Vv[tt * NR + lane - rbase] = v;
            if (write_rk && lane == 0) RK[(size_t)row * 16 + h] = rk;
        }
        __syncthreads();
        if (tid < 256) {
#pragma unroll 2
            for (int tt = 0; tt < TB; ++tt) {
                const f32x4 w4 = *(const LAS f32x4*)(Wd + tt * 64 + 4 * jp), kk4 = *(const LAS f32x4*)(KK + tt * 64 + 4 * jp), ka4 = *(const LAS f32x4*)(KA + tt * 64 + 4 * jp),
                            kb4 = *(const LAS f32x4*)(KB + tt * 64 + 4 * jp), r4 = *(const LAS f32x4*)(R + tt * 64 + 4 * jp);
#pragma unroll
                for (int rr = 0; rr < RPL; ++rr) {
                    const float v = Vv[tt * NR + il + 16 * rr];
                    float sa = (S[rr][0] * kk4.x + S[rr][1] * kk4.y) + (S[rr][2] * kk4.z + S[rr][3] * kk4.w);
                    sa = -row16_sum(sa);
                    S[rr][0] = S[rr][0] * w4.x + (sa * ka4.x + v * kb4.x); S[rr][1] = S[rr][1] * w4.y + (sa * ka4.y + v * kb4.y);
                    S[rr][2] = S[rr][2] * w4.z + (sa * ka4.z + v * kb4.z); S[rr][3] = S[rr][3] * w4.w + (sa * ka4.w + v * kb4.w);
                    float y = (S[rr][0] * r4.x + S[rr][1] * r4.y) + (S[rr][2] * r4.z + S[rr][3] * r4.w);
                    y = row16_sum(y);
                    if (jp == 0) Yo[tt * NR + il + 16 * rr] = y;
                }
            }
        }
        __syncthreads();
        for (int idx = tid; idx < TB * NR; idx += NTHR) { const int tt = idx / NR, i = idx - tt * NR; YRAW[(size_t)(row0 + t0 + tt) * 1024 + h * 64 + rbase + i] = Yo[idx]; }
    }
    if (tid < 256) {
#pragma unroll
        for (int rr = 0; rr < RPL; ++rr) *(GAS f32x4*)(st_out + (size_t)(rbase + il + 16 * rr) * 64 + 4 * jp) = (f32x4){S[rr][0], S[rr][1], S[rr][2], S[rr][3]};
    }
}

template <int VPL>
__device__ __forceinline__ void ret_unit(LAS float* L, const bf16* Z, const f32x2* ROT, int s, int h, int vs, const float* st_in, float* st_out, float* ORAW, int tid) {
    constexpr int TB = VPL == 1 ? 32 : 8, NV = 16 * VPL;
    LAS float* Q = L; LAS float* K = Q + TB * 256; LAS float* V = K + TB * 256; LAS float* OP = V + TB * NV;
    const int T = seq_T(s), row0 = seq_row0(s), pbase = s < NPB ? 0 : 2048;
    const int w = tid >> 6, lane = tid & 63, vl = lane >> 2, dl = lane & 3, dk0 = 32 * w + 8 * dl;
    const int vcol0 = vs * NV + vl * VPL;
    const float gamma = 1.0f - exp2f(-5.0f - (float)h);
    float S[VPL][8];
#pragma unroll
    for (int c = 0; c < VPL; ++c)
#pragma unroll
        for (int e = 0; e < 8; ++e) S[c][e] = st_in ? st_in[(size_t)(dk0 + e) * 256 + vcol0 + c] : 0.f;
    for (int t0 = 0; t0 < T; t0 += TB) {
        __syncthreads();
        for (int idx = tid; idx < TB * 128; idx += NTHR) {
            const int tt = idx >> 7, pi = idx & 127; const size_t zo = (size_t)(row0 + t0 + tt) * DINO + h * 256 + 2 * pi;
            const f32x2 sc = ROT[(size_t)(pbase + t0 + tt) * 128 + pi];
            const unsigned qw = *(const GAS unsigned*)(Z + zo), kw = *(const GAS unsigned*)(Z + zo + 1024);
            const float q1 = bflo(qw), q2 = bfhi(qw), k1 = bflo(kw) * 0.0625f, k2 = bfhi(kw) * 0.0625f;
            *(LAS f32x2*)(Q + tt * 256 + 2 * pi) = (f32x2){q1 * sc.y - q2 * sc.x, q2 * sc.y + q1 * sc.x};
            *(LAS f32x2*)(K + tt * 256 + 2 * pi) = (f32x2){k1 * sc.y - k2 * sc.x, k2 * sc.y + k1 * sc.x};
        }
        for (int idx = tid; idx < TB * NV; idx += NTHR) { const int tt = idx / NV, c = idx - tt * NV; V[idx] = bf2f(Z[(size_t)(row0 + t0 + tt) * DINO + 2048 + h * 256 + vs * NV + c]); }
        __syncthreads();
#pragma unroll 2
        for (int tt = 0; tt < TB; ++tt) {
            const f32x4 qa = *(const LAS f32x4*)(Q + tt * 256 + dk0), qb = *(const LAS f32x4*)(Q + tt * 256 + dk0 + 4), ka = *(const LAS f32x4*)(K + tt * 256 + dk0), kb = *(const LAS f32x4*)(K + tt * 256 + dk0 + 4);
            const float q8[8] = {qa.x, qa.y, qa.z, qa.w, qb.x, qb.y, qb.z, qb.w}, k8[8] = {ka.x, ka.y, ka.z, ka.w, kb.x, kb.y, kb.z, kb.w};
#pragma unroll
            for (int c = 0; c < VPL; ++c) {
                const float v = V[tt * NV + vl * VPL + c]; float o = 0.f;
#pragma unroll
                for (int e = 0; e < 8; ++e) { S[c][e] = gamma * S[c][e] + k8[e] * v; o += S[c][e] * q8[e]; }
                o = quad_sum(o);
                if (dl == 0) OP[(w * TB + tt) * NV + vl * VPL + c] = o;
            }
        }
        __syncthreads();
        for (int idx = tid; idx < TB * NV; idx += NTHR) { const int tt = idx / NV, c = idx - tt * NV; float o = 0.f;
#pragma unroll
            for (int ww = 0; ww < 8; ++ww) o += OP[(ww * TB + tt) * NV + c];
            ORAW[(size_t)(row0 + t0 + tt) * 1024 + h * 256 + vs * NV + c] = o; }
    }
#pragma unroll
    for (int c = 0; c < VPL; ++c)
#pragma unroll
        for (int e = 0; e < 8; ++e) st_out[(size_t)(dk0 + e) * 256 + vcol0 + c] = S[c][e];
}

struct LruP { const float *cw, *cb, *lam; };
template <bool WRITE>
__device__ __forceinline__ f32x2 rglru_seg(const bf16* Z, const float* SG, bf16* O, const LruP P, int s, int ch, int tb, int n, float h0, const float* st_conv) {
    const int row0 = seq_row0(s); const bool prompt = s < NPB;
    const float lam_sp = log1pf(__expf(-P.lam[ch]));
    const float cw0 = P.cw[ch], cw1 = P.cw[1024 + ch], cw2 = P.cw[2048 + ch], cw3 = P.cw[3072 + ch], cb = P.cb[ch];
    float x3, x2, x1;
    {
        float tap[3];
#pragma unroll
        for (int m = 0; m < 3; ++m) { const int tm = tb - 3 + m;
            tap[m] = tm >= 0 ? bf2f(Z[(size_t)(row0 + tm) * DINO + 5120 + ch]) : (st_conv ? st_conv[(size_t)(3 + tm) * 1024 + ch] : 0.f); }
        x3 = tap[0]; x2 = tap[1]; x1 = tap[2];
    }
    float hh = h0, A = 1.0f;
    for (int t = tb; t < tb + n; ++t) {
        const size_t row = (size_t)(row0 + t);
        const float x0 = bf2f(Z[row * DINO + 5120 + ch]);
        const float xc = cb + ((cw0 * x3 + cw1 * x2) + (cw2 * x1 + cw3 * x0));
        const float rg = sigm(SG[row * 2048 + ch]), ig = sigm(SG[row * 2048 + 1024 + ch]);
        const float a = __expf(-8.0f * rg * lam_sp);
        const float mult = (prompt && t == 0) ? 1.0f : sqrtf(fmaxf(1.0f - a * a, 0.f));
        hh = a * hh + mult * ig * xc; A *= a;
        if (WRITE) { const float y = bf2f(Z[row * DINO + 4096 + ch]); const float u = 0.7978845608f * (y + 0.044715f * y * y * y);
            O[row * 2048 + 1024 + ch] = (bf16)f2bf(hh * y * sigm(2.0f * u)); }
        x3 = x2; x2 = x1; x1 = x0;
    }
    return (f32x2){A, hh};
}

#define CAS __attribute__((address_space(4)))
struct Args { const float* in[38]; float* out; unsigned char* ws; int ph_lo, ph_hi; };
__device__ __forceinline__ int opaque_tid() { int t = threadIdx.x; asm volatile("" : "+v"(t)); return t; }
__device__ __forceinline__ const CAS Args* opaque_args() { size_t z = 0; asm volatile("" : "+s"(z)); return (const CAS Args*)((const CAS char*)__builtin_amdgcn_kernarg_segment_ptr() + z); }
#ifndef MK_ONE_LAUNCH
#define MK_ONE_LAUNCH 1
#endif
#ifndef DIS_P0
#define DIS_P0 0
#endif
#ifndef DIS_A
#define DIS_A 0
#endif
#ifndef DIS_B
#define DIS_B 0
#endif
#ifndef DIS_C
#define DIS_C 0
#endif
#ifndef DIS_D
#define DIS_D 0
#endif
#ifndef DIS_E
#define DIS_E 0
#endif
#ifndef DIS_A2
#define DIS_A2 0
#endif
#ifndef DIS_F
#define DIS_F 0
#endif
#ifndef DIS_G
#define DIS_G 0
#endif
constexpr int N_PHASES = 39;

__global__ void __launch_bounds__(NTHR, 2) mega_fwd(Args args) {
    extern __shared__ __attribute__((aligned(16))) unsigned char lds_raw[];
    LAS unsigned char* lds = (LAS unsigned char*)lds_raw;
    volatile LAS unsigned* MISC = (volatile LAS unsigned*)(lds + MISC_OFF);
    const int G = gridDim.x, bx = blockIdx.x;
    for (int u = threadIdx.x; u < (LDS_BYTES - LDSCTL_OFF) / 4; u += NTHR) ((LAS unsigned*)(lds + LDSCTL_OFF))[u] = 0u;
    __syncthreads();
#if MK_ONE_LAUNCH
    XcdBarrier bar = xcd_barrier_post((unsigned*)(args.ws + WS_CTL) + CW_BAR, MISC + 8);
#define GRID_BAR() xcd_barrier(bar)
#else
#define GRID_BAR() do { } while (0)
#endif
    const int lo = args.ph_lo, hi = args.ph_hi;
    int ph = 0;
#define IN_PH (lo <= ph && ph < hi)
#define END_PH do { if (IN_PH && (ph + 1) < hi) GRID_BAR(); ++ph; } while (0)

#define PHASE_ENV \
    const int tid = opaque_tid(); const int lane = tid & 63, wave = __builtin_amdgcn_readfirstlane(tid >> 6); \
    const int gw = bx * NWAVES + wave, NGW = G * NWAVES, gt = bx * NTHR + tid, NGT = G * NTHR; (void)gw; (void)NGW; (void)gt; (void)NGT; (void)lane; \
    const CAS Args* ap = opaque_args(); unsigned char* ws = ap->ws; float* out = ap->out; (void)out; \
    bf16* HN = (bf16*)(ws + WS_HN); bf16* Z = (bf16*)(ws + WS_Z); bf16* OB = (bf16*)(ws + WS_O); float* MIX = (float*)(ws + WS_MIX); bf16* ACT = (bf16*)(ws + WS_ACT); \
    bf16* SA = (bf16*)(ws + WS_SA); float* SG = (float*)(ws + WS_SG); float* ORAW = (float*)(ws + WS_ORAW); float* YRAW = (float*)(ws + WS_YRAW); float* RKB = (float*)(ws + WS_RK); \
    const f32x2* ROT = (const f32x2*)(ws + WS_ROT); (void)HN; (void)Z; (void)OB; (void)MIX; (void)ACT; (void)SA; (void)SG; (void)ORAW; (void)YRAW; (void)RKB; (void)ROT;
#define AIN(k) (ap->in[k])

    if (IN_PH && !DIS_P0) { PHASE_ENV
        LAS unsigned char* scr = lds + RING_OFF + wave * 9216;
        constexpr int I_IE = (DM / 64) * (DINE / 64), I_OE = (DM / 64) * (DM / 64), I_IO = (DM / 64) * (DINO / 64), I_FI = (DM / 64) * (2 * DFF / 64), I_FO = (DFF / 64) * (DM / 64);
        constexpr int NITEMS = 2 * I_IE + 2 * I_OE + 2 * I_IO + 2 * I_OE + 4 * I_FI + 4 * I_FO;
        for (int it = gw; it < NITEMS; it += NGW) {
            int r = it;
            if (r < 2 * I_IE) { const int l = r / I_IE; p0_transpose_item(AIN(12) + (size_t)l * DM * DINE, DM, DINE, (bf16*)(ws + WS_WIE) + (size_t)l * DINE * DM, 0, scr, r - l * I_IE, lane); continue; } r -= 2 * I_IE;
            if (r < 2 * I_OE) { const int l = r / I_OE; p0_transpose_item(AIN(13) + (size_t)l * DM * DM, DM, DM, (bf16*)(ws + WS_WOE) + (size_t)l * DM * DM, 0, scr, r - l * I_OE, lane); continue; } r -= 2 * I_OE;
            if (r < 2 * I_IO) { const int l = r / I_IO; p0_transpose_item(AIN(27) + (size_t)l * DM * DINO, DM, DINO, (bf16*)(ws + WS_WIO) + (size_t)l * DINO * DM, 0, scr, r - l * I_IO, lane); continue; } r -= 2 * I_IO;
            if (r < 2 * I_OE) { const int l = r / I_OE; p0_transpose_item(AIN(28) + (size_t)l * DM * DM, DM, DM, (bf16*)(ws + WS_WOO) + (size_t)l * DM * DM, 0, scr, r - l * I_OE, lane); continue; } r -= 2 * I_OE;
            if (r < 4 * I_FI) { const int l = r / I_FI; p0_transpose_item(AIN(36) + (size_t)l * DM * 2 * DFF, DM, 2 * DFF, (bf16*)(ws + WS_WFI) + (size_t)l * 2 * DFF * DM, 1, scr, r - l * I_FI, lane); continue; } r -= 4 * I_FI;
            { const int l = r / I_FO; p0_transpose_item(AIN(37) + (size_t)l * DFF * DM, DFF, DM, (bf16*)(ws + WS_WFO) + (size_t)l * DM * DFF, 0, scr, r - l * I_FO, lane); }
        }
        for (int idx = gt; idx < 2 * 3072 * 256; idx += NGT) { const int jj = idx / (3072 * 256), r = idx - jj * 3072 * 256, n = r >> 8, k = r & 255; float v = 0.f;
            if (n < 1024) { if (k < 64) v = AIN(18)[((size_t)jj * 64 + k) * 1024 + n]; }
            else if (n < 2048) { if (k >= 64 && k < 128) v = AIN(20)[((size_t)jj * 64 + (k - 64)) * 1024 + (n - 1024)]; }
            else { if (k >= 128) v = AIN(21)[((size_t)jj * 128 + (k - 128)) * 1024 + (n - 2048)]; }
            ((bf16*)(ws + WS_WLR))[idx] = (bf16)f2bf(v); }
        for (int idx = gt; idx < 2 * 3072; idx += NGT) { const int jj = idx / 3072, n = idx - jj * 3072;
            ((float*)(ws + WS_BLR))[idx] = n < 1024 ? AIN(17)[jj * 1024 + n] : (n < 2048 ? AIN(19)[jj * 1024 + n - 1024] : 0.f); }
        for (int idx = gt; idx < 2 * 2048 * 256; idx += NGT) { const int jj = idx / (2048 * 256), r = idx - jj * 2048 * 256, n = r >> 8, k = r & 255, n2 = n & 1023, hd = n2 >> 8, jc = n2 & 255;
            const float* src = n < 1024 ? AIN(31) : AIN(33);
            ((bf16*)(ws + WS_WGT))[idx] = (bf16)f2bf(src[(((size_t)jj * 4 + hd) * 256 + k) * 256 + jc]); }
        for (int idx = gt; idx < 2 * 2048; idx += NGT) { const int jj = idx / 2048, n = idx - jj * 2048;
            ((float*)(ws + WS_BGT))[idx] = n < 1024 ? AIN(32)[jj * 1024 + n] : AIN(34)[jj * 1024 + n - 1024]; }
        for (int idx = gt; idx < 2056 * 128; idx += NGT) { const int pi = idx >> 7, i = idx & 127; const double pos = pi < 2048 ? (double)pi : (double)(16384 + pi - 2048);
            const double ang = pos * exp(-9.210340371976184 * ((double)i / 127.0));
            ((f32x2*)(ws + WS_ROT))[idx] = (f32x2){(float)sin(ang), (float)cos(ang)}; }
        for (int row = gw; row < M; row += NGW) {
            const float* xin = row < MP ? AIN(0) + (size_t)row * DM : AIN(1) + (size_t)(row - MP) * DM;
            norm_row<false, true>(xin, nullptr, out + (size_t)row * DM, nullptr, AIN(8), HN + (size_t)row * DM, lane);
        }
    }
    END_PH;

    for (int hl = 0; hl < 8; ++hl) {
        const int l = hl >> 1, j = l >> 1; const bool mixer = (hl & 1) == 0, even = (l & 1) == 0;
        if (mixer) {
            if (IN_PH && !DIS_A) { PHASE_ENV
                const int N = even ? DINE : DINO;
                const bf16* Bt = even ? (const bf16*)(ws + WS_WIE) + (size_t)j * DINE * DM : (const bf16*)(ws + WS_WIO) + (size_t)j * DINO * DM;
                pg8::Gemm g{HN, Bt, M, N, DM, DM, DM, 0}; pg8::StaticOrder S; S.init(M, N, G, bx);
                pg8::EpiBf16<0> E{Z, N, nullptr, 0, 0, 1.f};
                pg8::gemm_phase<pg8::EpiBf16<0>, pg8::StaticOrder, true, true>(lds + RING_OFF, g, S, E);
            }
            END_PH;
            if (IN_PH && !DIS_B) { PHASE_ENV
                LAS float* L = (LAS float*)(lds + RING_OFF);
                if (even) {
                    const float* mu = AIN(16) + (size_t)j * DRP; const float* st_shift = AIN(4) + (size_t)j * NDB * DRP;
                    for (int idx = gt; idx < M * 32; idx += NGT) {
                        const int row = idx >> 5, c8 = idx & 31; int t, s; row_ts(row, t, s);
                        const bf16* zr = Z + (size_t)row * DINE + 7168 + c8 * 8;
                        float c[8], p[8]; unpack8(*(const GAS v4u*)zr, c);
                        if (t > 0) unpack8(*(const GAS v4u*)(zr - DINE), p);
                        else {
#pragma unroll
                            for (int e = 0; e < 8; ++e) p[e] = s >= NPB ? st_shift[(size_t)(s - NPB) * DRP + 3072 + c8 * 8 + e] : 0.f; }
                        float o[8];
#pragma unroll
                        for (int e = 0; e < 8; ++e) { const float zs = c[e] + (p[e] - c[e]) * mu[3072 + c8 * 8 + e];
                            o[e] = c8 < 8 ? 2.0f * sigm(2.0f * zs) - 1.0f : (c8 < 16 ? zs : sigm(zs)); }
                        *(GAS v4u*)(SA + (size_t)row * 256 + c8 * 8) = pack8(o);
                    }
                    for (int idx = gt; idx < NSEQ * DRP; idx += NGT) { const int s = idx / DRP, c = idx - s * DRP;
                        st_out_ptr(out, O_SHIFT_P, O_SHIFT_S, DRP, j, s)[c] = bf2f(Z[(size_t)(seq_row0(s) + seq_T(s) - 1) * DINE + 4096 + c]); }
                    const float* lbraw = AIN(14);
                    for (int u = bx; u < 256 + 1024; u += G) {
                        if (u < 256) { const int s = u >> 6, h = (u >> 3) & 7, vs = u & 7;
                            hgrn_unit<1>(L, Z, j, s, h, vs, nullptr, st_out_ptr(out, O_HGRN_P, O_HGRN_S, SZ_HGRN, j, s) + (size_t)h * 16384, ORAW, lbraw, tid); }
                        else { const int u2 = u - 256, b = u2 >> 3, h = u2 & 7, s = NPB + b;
                            hgrn_unit<8>(L, Z, j, s, h, 0, AIN(2) + ((size_t)j * NDB + b) * SZ_HGRN + (size_t)h * 16384, st_out_ptr(out, O_HGRN_P, O_HGRN_S, SZ_HGRN, j, s) + (size_t)h * 16384, ORAW, lbraw, tid); }
                    }
                } else {
                    const float* cw = AIN(29) + (size_t)j * 4 * 1024; const float* cb = AIN(30) + (size_t)j * 1024; const float* st_conv = AIN(6) + (size_t)j * NDB * SZ_CONV;
                    for (int idx = gt; idx < M * 128; idx += NGT) {
                        const int row = idx >> 7, c8 = idx & 127, c0 = c8 * 8; int t, s; row_ts(row, t, s);
                        float acc[8];
#pragma unroll
                        for (int e = 0; e < 8; ++e) acc[e] = cb[c0 + e];
#pragma unroll
                        for (int m = 0; m < 4; ++m) { const int tm = t - 3 + m; float x[8];
                            if (tm >= 0) unpack8(*(const GAS v4u*)(Z + (size_t)(row - 3 + m) * DINO + 5120 + c0), x);
                            else {
#pragma unroll
                                for (int e = 0; e < 8; ++e) x[e] = s >= NPB ? st_conv[(size_t)(s - NPB) * SZ_CONV + (size_t)(3 + tm) * 1024 + c0 + e] : 0.f; }
#pragma unroll
                            for (int e = 0; e < 8; ++e) acc[e] += cw[m * 1024 + c0 + e] * x[e]; }
                        *(GAS v4u*)(SA + (size_t)row * 1024 + c0) = pack8(acc);
                    }
                    for (int idx = gt; idx < NSEQ * 3 * 1024; idx += NGT) { const int s = idx / 3072, r = (idx - s * 3072) >> 10, c = idx & 1023;
                        st_out_ptr(out, O_CONV_P, O_CONV_S, SZ_CONV, j, s)[r * 1024 + c] = bf2f(Z[(size_t)(seq_row0(s) + seq_T(s) - 3 + r) * DINO + 5120 + c]); }
                    for (int u = bx; u < 256 + 1024; u += G) {
                        if (u < 256) { const int s = u >> 6, h = (u >> 4) & 3, vs = u & 15;
                            ret_unit<1>(L, Z, ROT, s, h, vs, nullptr, st_out_ptr(out, O_RET_P, O_RET_S, SZ_RET, j, s) + (size_t)h * 65536, ORAW, tid); }
                        else { const int u2 = u - 256, b = u2 >> 3, h = (u2 >> 1) & 3, vs = u2 & 1, s = NPB + b;
                            ret_unit<8>(L, Z, ROT, s, h, vs, AIN(5) + ((size_t)j * NDB + b) * SZ_RET + (size_t)h * 65536, st_out_ptr(out, O_RET_P, O_RET_S, SZ_RET, j, s) + (size_t)h * 65536, ORAW, tid); }
                    }
                }
            }
            END_PH;
            if (IN_PH && !DIS_C) { PHASE_ENV
                const int N = even ? 3072 : 2048;
                const bf16* Bt = even ? (const bf16*)(ws + WS_WLR) + (size_t)j * 3072 * 256 : (const bf16*)(ws + WS_WGT) + (size_t)j * 2048 * 256;
                const float* bias = even ? (const float*)(ws + WS_BLR) + j * 3072 : (const float*)(ws + WS_BGT) + j * 2048;
                pg8::Gemm g{SA, Bt, M, N, 256, even ? 256 : 1024, 256, even ? 0 : 3}; pg8::StaticOrder S; S.init(M, N, G, bx);
                pg8::EpiF32 E{SG, N, bias};
                pg8::gemm_phase<pg8::EpiF32, pg8::StaticOrder, true, true>(lds + RING_OFF, g, S, E);
            }
            END_PH;
            if (IN_PH && !DIS_D) { PHASE_ENV
                LAS float* L = (LAS float*)(lds + RING_OFF);
                if (even) {
                    const RwkvP P{AIN(16) + (size_t)j * DRP, AIN(22) + (size_t)j * 1024, AIN(23) + (size_t)j * 1024, AIN(24) + (size_t)j * 1024};
                    for (int u = bx; u < 256 + 2048; u += G) {
                        if (u < 256) { const int s = u >> 6, h = (u >> 2) & 15, sl = u & 3;
                            rwkv_unit<1>(L, Z, SG, P, s, h, sl * 16, sl == 0, nullptr, nullptr, st_out_ptr(out, O_RWKV_P, O_RWKV_S, SZ_RWKV, j, s) + (size_t)h * 4096, YRAW, RKB, tid); }
                        else { const int u2 = u - 256, b = u2 >> 4, h = u2 & 15, s = NPB + b;
                            rwkv_unit<4>(L, Z, SG, P, s, h, 0, true, AIN(4) + ((size_t)j * NDB + b) * DRP, AIN(3) + ((size_t)j * NDB + b) * SZ_RWKV + (size_t)h * 4096,
                                         st_out_ptr(out, O_RWKV_P, O_RWKV_S, SZ_RWKV, j, s) + (size_t)h * 4096, YRAW, RKB, tid); }
                    }
                } else {
                    for (int row = gw; row < M; row += NGW) {
                        const GAS f32x4* orow = (const GAS f32x4*)(ORAW + (size_t)row * 1024 + 16 * lane);
                        float o[16];
#pragma unroll
                        for (int q = 0; q < 4; ++q) { const f32x4 v = orow[q]; o[4 * q] = v.x; o[4 * q + 1] = v.y; o[4 * q + 2] = v.z; o[4 * q + 3] = v.w; }
                        float ss = 0.f;
#pragma unroll
                        for (int e = 0; e < 16; ++e) ss += o[e] * o[e];
                        const float rs = rsqrtf(row16_sum(ss) * (1.0f / 256.0f) + RMS_EPS);
                        float g[16]; { float t8[8]; unpack8(*(const GAS v4u*)(Z + (size_t)row * DINO + 3072 + 16 * lane), t8);
#pragma unroll
                            for (int e = 0; e < 8; ++e) g[e] = t8[e];
                            unpack8(*(const GAS v4u*)(Z + (size_t)row * DINO + 3072 + 16 * lane + 8), t8);
#pragma unroll
                            for (int e = 0; e < 8; ++e) g[8 + e] = t8[e]; }
                        float r0[8], r1[8];
#pragma unroll
                        for (int e = 0; e < 8; ++e) { r0[e] = o[e] * rs * siluf(g[e]); r1[e] = o[8 + e] * rs * siluf(g[8 + e]); }
                        *(GAS v4u*)(OB + (size_t)row * DM + 16 * lane) = pack8(r0); *(GAS v4u*)(OB + (size_t)row * DM + 16 * lane + 8) = pack8(r1);
                    }
                    const LruP P{AIN(29) + (size_t)j * 4 * 1024, AIN(30) + (size_t)j * 1024, AIN(35) + (size_t)j * 1024};
                    for (int u = bx; u < 256; u += G) {
                        const int s = u >> 6, cg = u & 63, cl = tid & 15, ch = cg * 16 + cl, chunk = tid >> 4;
                        __syncthreads();
                        const f32x2 ah = rglru_seg<false>(Z, SG, OB, P, s, ch, chunk * 64, 64, 0.f, nullptr);
                        L[chunk * 16 + cl] = ah.x; L[512 + chunk * 16 + cl] = ah.y;
                        __syncthreads();
                        float hin = 0.f;
                        for (int c2 = 0; c2 < chunk; ++c2) hin = L[c2 * 16 + cl] * hin + L[512 + c2 * 16 + cl];
                        const f32x2 r = rglru_seg<true>(Z, SG, OB, P, s, ch, chunk * 64, 64, hin, nullptr);
                        if (chunk == 31) st_out_ptr(out, O_H_P, O_H_S, 1024, j, s)[ch] = r.y;
                    }
                    for (int idx = gt; idx < NDB * 1024; idx += NGT) { const int b = idx >> 10, ch = idx & 1023, s = NPB + b;
                        const f32x2 r = rglru_seg<true>(Z, SG, OB, P, s, ch, 0, DSEQ, AIN(7)[((size_t)j * NDB + b) * 1024 + ch], AIN(6) + ((size_t)j * NDB + b) * SZ_CONV);
                        st_out_ptr(out, O_H_P, O_H_S, 1024, j, s)[ch] = r.y; }
                }
            }
            END_PH;
            if (even) {
                if (IN_PH && !DIS_E) { PHASE_ENV
                    const float* nw = AIN(15) + (size_t)j * 1024; const float* lnw = AIN(25) + (size_t)j * 1024; const float* lnb = AIN(26) + (size_t)j * 1024;
                    const float* mu = AIN(16) + (size_t)j * DRP + 2048; const float* st_shift = AIN(4) + (size_t)j * NDB * DRP;
                    for (int row = gw; row < M; row += NGW) {
                        int t, s; row_ts(row, t, s);
                        const int c0 = 16 * lane;
                        {
                            const GAS f32x4* orow = (const GAS f32x4*)(ORAW + (size_t)row * 1024 + c0);
                            float o[16];
#pragma unroll
                            for (int q = 0; q < 4; ++q) { const f32x4 v = orow[q]; o[4 * q] = v.x; o[4 * q + 1] = v.y; o[4 * q + 2] = v.z; o[4 * q + 3] = v.w; }
                            float ss = 0.f;
#pragma unroll
                            for (int e = 0; e < 16; ++e) ss += o[e] * o[e];
                            const float rs = rsqrtf(oct_sum(ss) * (1.0f / 128.0f) + RMS_EPS);
                            float g0[8], g1[8]; unpack8(*(const GAS v4u*)(Z + (size_t)row * DINE + 3072 + c0), g0); unpack8(*(const GAS v4u*)(Z + (size_t)row * DINE + 3072 + c0 + 8), g1);
                            float r0[8], r1[8];
#pragma unroll
                            for (int e = 0; e < 8; ++e) { r0[e] = o[e] * rs * nw[c0 + e] * siluf(g0[e]); r1[e] = o[8 + e] * rs * nw[c0 + 8 + e] * siluf(g1[e]); }
                            *(GAS v4u*)(OB + (size_t)row * DM + c0) = pack8(r0); *(GAS v4u*)(OB + (size_t)row * DM + c0 + 8) = pack8(r1);
                        }
                        {
                            const GAS f32x4* yrow = (const GAS f32x4*)(YRAW + (size_t)row * 1024 + c0);
                            float y[16];
#pragma unroll
                            for (int q = 0; q < 4; ++q) { const f32x4 v = yrow[q]; y[4 * q] = v.x; y[4 * q + 1] = v.y; y[4 * q + 2] = v.z; y[4 * q + 3] = v.w; }
                            float sm = 0.f;
#pragma unroll
                            for (int e = 0; e < 16; ++e) sm += y[e];
                            const float mean = quad_sum(sm) * (1.0f / 64.0f); float sv = 0.f;
#pragma unroll
                            for (int e = 0; e < 16; ++e) { const float d = y[e] - mean; sv += d * d; }
                            const float rstd = rsqrtf(quad_sum(sv) * (1.0f / 64.0f) + GN_EPS);
                            const bf16* zv = Z + (size_t)row * DINE + 4096 + 2048 + c0;
                            float v0[8], v1[8], p0[8], p1[8]; unpack8(*(const GAS v4u*)zv, v0); unpack8(*(const GAS v4u*)(zv + 8), v1);
                            if (t > 0) { unpack8(*(const GAS v4u*)(zv - DINE), p0); unpack8(*(const GAS v4u*)(zv - DINE + 8), p1); }
                            else {
#pragma unroll
                                for (int e = 0; e < 8; ++e) { p0[e] = s >= NPB ? st_shift[(size_t)(s - NPB) * DRP + 2048 + c0 + e] : 0.f; p1[e] = s >= NPB ? st_shift[(size_t)(s - NPB) * DRP + 2048 + c0 + 8 + e] : 0.f; } }
                            const float rk = RKB[(size_t)row * 16 + (lane >> 2)];
                            const GAS f32x4* grow = (const GAS f32x4*)(SG + (size_t)row * 3072 + 2048 + c0);
                            float gt_[16];
#pragma unroll
                            for (int q = 0; q < 4; ++q) { const f32x4 v = grow[q]; gt_[4 * q] = v.x; gt_[4 * q + 1] = v.y; gt_[4 * q + 2] = v.z; gt_[4 * q + 3] = v.w; }
                            float r0[8], r1[8];
#pragma unroll
                            for (int e = 0; e < 8; ++e) {
                                const float va = v0[e] + (p0[e] - v0[e]) * mu[c0 + e], vb = v1[e] + (p1[e] - v1[e]) * mu[c0 + 8 + e];
                                r0[e] = ((y[e] - mean) * rstd * lnw[c0 + e] + lnb[c0 + e] + rk * va) * gt_[e];
                                r1[e] = ((y[8 + e] - mean) * rstd * lnw[c0 + 8 + e] + lnb[c0 + 8 + e] + rk * vb) * gt_[8 + e]; }
                            *(GAS v4u*)(OB + (size_t)row * DM + 1024 + c0) = pack8(r0); *(GAS v4u*)(OB + (size_t)row * DM + 1024 + c0 + 8) = pack8(r1);
                        }
                    }
                }
                END_PH;
            }
        } else {
            if (IN_PH && !DIS_A2) { PHASE_ENV
                pg8::Gemm g{HN, (const bf16*)(ws + WS_WFI) + (size_t)l * 2 * DFF * DM, M, 2 * DFF, DM, DM, DM, 0}; pg8::StaticOrder S; S.init(M, 2 * DFF, G, bx);
                pg8::EpiSwiGLU E{ACT, DFF};
                pg8::gemm_phase<pg8::EpiSwiGLU, pg8::StaticOrder, true, true>(lds + RING_OFF, g, S, E);
            }
            END_PH;
        }
        if (IN_PH && !DIS_F) { PHASE_ENV
            const bf16* A = mixer ? OB : ACT; const int K = mixer ? DM : DFF;
            const bf16* Bt = mixer ? (even ? (const bf16*)(ws + WS_WOE) : (const bf16*)(ws + WS_WOO)) + (size_t)j * DM * DM : (const bf16*)(ws + WS_WFO) + (size_t)l * DM * DFF;
            pg8::Gemm g{A, Bt, M, DM, K, K, K, 0}; pg8::StaticOrder S; S.init(M, DM, G, bx);
            pg8::EpiF32 E{MIX, DM, nullptr};
            pg8::gemm_phase<pg8::EpiF32, pg8::StaticOrder, true, true>(lds + RING_OFF, g, S, E);
        }
        END_PH;
        if (IN_PH && !DIS_G) { PHASE_ENV
            const float* wpost = (mixer ? AIN(9) : AIN(11)) + (size_t)l * DM;
            const float* wpre = mixer ? AIN(10) + (size_t)l * DM : AIN(8) + (size_t)(l + 1 < 4 ? l + 1 : 0) * DM;
            if (hl < 7) { for (int row = gw; row < M; row += NGW) norm_row<true, true>(out + (size_t)row * DM, MIX + (size_t)row * DM, out + (size_t)row * DM, wpost, wpre, HN + (size_t)row * DM, lane); }
            else { for (int row = gw; row < M; row += NGW) norm_row<true, false>(out + (size_t)row * DM, MIX + (size_t)row * DM, out + (size_t)row * DM, wpost, wpre, HN + (size_t)row * DM, lane); }
        }
        END_PH;
    }
}

extern "C" void kernel_launch(void* const* d_in, const int* in_sizes, int n_in, void* d_out, int out_size, void* d_ws, size_t ws_size, hipStream_t stream) {
    static int grid = 0;
    if (grid == 0) {
        if (n_in != 38 || (size_t)out_size != O_END || ws_size < WS_END) { fprintf(stderr, "kernel_launch: unexpected sizes: n_in %d out %d ws %zu (need %zu)\n", n_in, out_size, ws_size, (size_t)WS_END); grid = -1; return; }
        int dev = 0, cus = 0, per_cu = 0;
        if (hipGetDevice(&dev) != hipSuccess || hipDeviceGetAttribute(&cus, hipDeviceAttributeMultiprocessorCount, dev) != hipSuccess) { grid = -1; return; }
        if (hipFuncSetAttribute((const void*)mega_fwd, hipFuncAttributeMaxDynamicSharedMemorySize, LDS_BYTES) != hipSuccess) { fprintf(stderr, "kernel_launch: hipFuncSetAttribute failed\n"); grid = -1; return; }
        if (hipOccupancyMaxActiveBlocksPerMultiprocessor(&per_cu, (const void*)mega_fwd, NTHR, LDS_BYTES) != hipSuccess || per_cu < 1) fprintf(stderr, "kernel_launch: occupancy query says %d\n", per_cu);
        (void)hipGetLastError();
        grid = cus;
    }
    if (grid < 0) return;
    (void)hipMemsetAsync((char*)d_ws + WS_CTL, 0, CTL_BYTES, stream);
    Args a{};
    for (int i = 0; i < 38; ++i) a.in[i] = (const float*)d_in[i];
    a.out = (float*)d_out; a.ws = (unsigned char*)d_ws;
#if MK_ONE_LAUNCH
    a.ph_lo = 0; a.ph_hi = N_PHASES;
    hipLaunchKernelGGL(mega_fwd, dim3(grid), dim3(NTHR), LDS_BYTES, stream, a);
#else
    for (int p = 0; p < N_PHASES; ++p) { a.ph_lo = p; a.ph_hi = p + 1; hipLaunchKernelGGL(mega_fwd, dim3(grid), dim3(NTHR), LDS_BYTES, stream, a); }
#endif
}
```

```cpp
#include <hip/hip_runtime.h>
#include <cstdio>
#include <cstdint>
namespace pg8 {
#define PG8_LAS __attribute__((address_space(3)))
typedef unsigned short bf16_t;
typedef short bf16x8 __attribute__((ext_vector_type(8)));
typedef float f32x4 __attribute__((ext_vector_type(4)));
typedef unsigned u32x4 __attribute__((ext_vector_type(4)));
constexpr int BM = 256, BK = 64, HALF = 128, HTB = HALF * BK * 2  , STAGE_BYTES = 8 * HTB, NXCD = 8, WGM = 8;

__host__ __device__ __forceinline__ int lds_byte(int r, int c) { const int st = (r >> 4) * 2 + (c >> 5), rr = r & 15, cc = c & 31, ob = rr * 64 + cc * 2; return st * 1024 + (ob ^ (((ob >> 9) & 1) << 5)); }
__host__ __device__ __forceinline__ void stage_rc(int b, int& R, int& C) { const int st = b / 1024, sb = b % 1024, swz = sb ^ (((sb >> 9) & 1) << 5); R = (st >> 1) * 16 + swz / 64; C = (st & 1) * 32 + (swz % 64) / 2; }
__host__ __device__ __forceinline__ int perm32(int rho) { const int n = rho >> 4, i = rho & 15; return 8 * (i >> 2) + 4 * n + (i & 3); }

struct Unit { int pm, pn, kt0, nt, part; };
struct Gemm { const bf16_t* A; const bf16_t* Bt; int M, N, K, lda, ldb, amask; };

struct StaticOrder {
    int nM, nN, nwg, G, c, ntK;
    __host__ __device__ void init(int M, int N, int G_, int c_, int K_) { nM = M / BM; nN = N / BM; nwg = nM * nN; G = G_; c = c_; ntK = K_ / BK; }
    __host__ __device__ __forceinline__ bool next(int i, Unit& u) const {
        u.pm = 0; u.pn = 0; u.kt0 = 0; u.nt = ntK; u.part = -1; const long L = (long)i * G + c; if (L >= nwg) return false;
        int wgid = (int)L; { const int q = nwg / NXCD, r = nwg % NXCD, xcd = wgid % NXCD, off = wgid / NXCD; wgid = (xcd < r ? xcd * (q + 1) : r * (q + 1) + (xcd - r) * q) + off; }
        const int nig = WGM * nN, gid = wgid / nig, fm = gid * WGM, gsz = (nM - fm) < WGM ? (nM - fm) : WGM;
        u.pm = fm + ((wgid % nig) % gsz); u.pn = (wgid % nig) / gsz; u.kt0 = 0; u.nt = ntK; u.part = -1; return true;
    }
    __device__ __forceinline__ void a_ready(const Unit&) const {}
    __device__ __forceinline__ void done(const Unit&) const {}
};

struct FOrder {
    StaticOrder s0; bool split; int c, ntK;
    __host__ __device__ void init(int M, int N, int G_, int c_, int K_) { split = (G_ == 256 && M == 9216 && N == 2048); c = c_; ntK = K_ / BK; s0.init(split ? 8192 : M, N, G_, c_, K_); }
    __host__ __device__ __forceinline__ bool next(int i, Unit& u) const {
        Unit a; const bool oka = s0.next(i, a);
        const int lu = c >> 3, pi = c & 7;
        const int pairs = ntK >> 1, q = pairs >> 3, r = pairs & 7;
        const int p0 = pi < 8 - r ? pi * q : (8 - r) * q + (pi - (8 - r)) * (q + 1), np = pi < 8 - r ? q : q + 1;
        const bool piece = split && i == 1;
        u.pm = piece ? 32 + (lu >> 3) : a.pm; u.pn = piece ? (lu & 7) : a.pn; u.kt0 = piece ? 2 * p0 : a.kt0; u.nt = piece ? 2 * np : a.nt; u.part = piece ? pi : a.part;
        return split ? (i <= 1) : oka;
    }
    __device__ __forceinline__ void a_ready(const Unit&) const {}
    __device__ __forceinline__ void done(const Unit&) const {}
};

__device__ __forceinline__ unsigned cvt_pk_bf16(float lo, float hi) { unsigned r; asm volatile("v_cvt_pk_bf16_f32 %0, %1, %2" : "=v"(r) : "v"(lo), "v"(hi)); return r; }
typedef float f32x2 __attribute__((ext_vector_type(2)));
template <int ACT  > struct EpiBf16 {
    static constexpr bool PERM = true, AFTER_DRAIN = false; static_assert(ACT == 0, "EpiBf16: ACT is 0");
    bf16_t* O; int ldc; const float* bias; int split_cols; size_t split_stride; float scale0;
    __device__ __forceinline__ void operator()(const f32x4 (&acc)[2][2][4][2], const Unit& u, int wr, int wc, int fr, int fq) const {
        const int row0 = u.pm * BM + wr * 64 + fr; int colt = u.pn * BM; bf16_t* base = O;
        float sc = 1.f; if (split_cols) { const int t = colt / split_cols; base += (size_t)t * split_stride; colt -= t * split_cols; if (t == 0) sc = scale0; }
        const int col0 = colt + wc * 32 + 8 * fq, bcol0 = u.pn * BM + wc * 32 + 8 * fq;
        f32x4 bv[2][2];
#pragma unroll
        for (int bj = 0; bj < 2; ++bj)
#pragma unroll
            for (int n = 0; n < 2; ++n) bv[bj][n] = bias ? *(const f32x4*)(bias + bcol0 + bj * HALF + 4 * n) : (f32x4){0.f, 0.f, 0.f, 0.f};
#pragma unroll
        for (int ai = 0; ai < 2; ++ai)
#pragma unroll
            for (int m = 0; m < 4; ++m) { bf16_t* rowp = base + (size_t)(row0 + ai * HALF + m * 16) * ldc + col0;
#pragma unroll
                for (int bj = 0; bj < 2; ++bj) { f32x4 v0 = acc[ai][bj][m][0] + bv[bj][0], v1 = acc[ai][bj][m][1] + bv[bj][1];

                    v0 = v0 * sc; v1 = v1 * sc; u32x4 w; w.x = cvt_pk_bf16(v0[0], v0[1]); w.y = cvt_pk_bf16(v0[2], v0[3]); w.z = cvt_pk_bf16(v1[0], v1[1]); w.w = cvt_pk_bf16(v1[2], v1[3]);
                    *(u32x4*)(rowp + bj * HALF) = w; } }
    }
};


struct EpiF32 {
    static constexpr bool PERM = false, AFTER_DRAIN = false;
    float* C; int ldc; const float* bias; float* P; size_t pstride; int prow0;
    __device__ __forceinline__ void operator()(const f32x4 (&acc)[2][2][4][2], const Unit& u, int wr, int wc, int fr, int fq) const {
        const int row0 = u.pm * BM + wr * 64 + fr, col0 = u.pn * BM + wc * 32 + 4 * fq;
        float* C = u.part >= 0 ? P + (size_t)u.part * pstride - (size_t)prow0 * ldc : this->C;
        f32x4 bv[2][2];
#pragma unroll
        for (int bj = 0; bj < 2; ++bj)
#pragma unroll
            for (int n = 0; n < 2; ++n) bv[bj][n] = bias ? *(const f32x4*)(bias + col0 + bj * HALF + n * 16) : (f32x4){0.f, 0.f, 0.f, 0.f};
#pragma unroll
        for (int ai = 0; ai < 2; ++ai)
#pragma unroll
            for (int m = 0; m < 4; ++m) { float* rowp = C + (size_t)(row0 + ai * HALF + m * 16) * ldc + col0;
#pragma unroll
                for (int bj = 0; bj < 2; ++bj)
#pragma unroll
                    for (int n = 0; n < 2; ++n) *(f32x4*)(rowp + bj * HALF + n * 16) = acc[ai][bj][m][n] + bv[bj][n]; }
    }
};
struct EpiSwiGLU {
    static constexpr bool PERM = true, AFTER_DRAIN = false;
    bf16_t* O; int ldc;
    __device__ __forceinline__ static float sw(float g, float u) { return g * u * __builtin_amdgcn_rcpf(1.0f + __builtin_amdgcn_exp2f(-1.44269504f * g)); }
    __device__ __forceinline__ void operator()(const f32x4 (&acc)[2][2][4][2], const Unit& u, int wr, int wc, int fr, int fq) const {
        const int row0 = u.pm * BM + wr * 64 + fr, col0 = u.pn * HALF + wc * 32 + 8 * fq;
#pragma unroll
        for (int ai = 0; ai < 2; ++ai)
#pragma unroll
            for (int m = 0; m < 4; ++m) { bf16_t* rowp = O + (size_t)(row0 + ai * HALF + m * 16) * ldc + col0;
                const f32x4 g0 = acc[ai][0][m][0], g1 = acc[ai][0][m][1], u0 = acc[ai][1][m][0], u1 = acc[ai][1][m][1];
                u32x4 w; w.x = cvt_pk_bf16(sw(g0[0], u0[0]), sw(g0[1], u0[1])); w.y = cvt_pk_bf16(sw(g0[2], u0[2]), sw(g0[3], u0[3]));
                w.z = cvt_pk_bf16(sw(g1[0], u1[0]), sw(g1[1], u1[1])); w.w = cvt_pk_bf16(sw(g1[2], u1[2]), sw(g1[3], u1[3]));
                *(u32x4*)rowp = w; }
    }
};
template <class Epi, class Sched, bool ALIGN_EPI = false, bool SP2 = false>
__device__ __forceinline__ void gemm_phase(PG8_LAS unsigned char* lds, const Gemm g, const Sched& S, const Epi& E) {
    int tid_ = threadIdx.x; asm volatile("" : "+v"(tid_)); const int tid = tid_, wid = __builtin_amdgcn_readfirstlane(tid >> 6), lane = tid & 63, wr = wid >> 2, wc = wid & 3, fr = lane & 15, fq = lane >> 4;
    unsigned voffA[2], voffB[2];
#pragma unroll
    for (int i = 0; i < 2; ++i) { int R, C; stage_rc(tid * 16 + i * 8192, R, C); const int Rb = Epi::PERM ? ((R & ~31) + perm32(R & 31)) : R;
        voffA[i] = (unsigned)(R * g.lda + C) * 2u; voffB[i] = (unsigned)(Rb * g.ldb + C) * 2u; }
    const size_t kstep = (size_t)(BK * 2);
    const size_t hstepA = (size_t)HALF * g.lda * 2, hstepB = (size_t)HALF * g.ldb * 2;
    const size_t tstepA = 2 * hstepA, tstepB = 2 * hstepB;
    const unsigned ldsw = (unsigned)wid * 1024u;
    const int aoff = lds_byte(wr * 64 + fr, fq * 8), boff = lds_byte(wc * 32 + fr, fq * 8);
#define PG8_SA(b, h) (((b) * 2 + (h)) * HTB)
#define PG8_SB(b, h) ((4 + (b) * 2 + (h)) * HTB)
#define PG8_STAGE(bufoff, gbase, voff) do { _Pragma("unroll") for (int _i = 0; _i < 2; ++_i) \
        __builtin_amdgcn_global_load_lds((const unsigned*)((const char*)(gbase) + (voff)[_i]), (PG8_LAS unsigned*)(lds + (bufoff) + ldsw + _i * 8192), 16, 0, 0); } while (0)
#define PG8_LDA(dst, b, h) do { _Pragma("unroll") for (int m = 0; m < 4; ++m) _Pragma("unroll") for (int k = 0; k < 2; ++k) dst[m][k] = *(const PG8_LAS bf16x8*)(lds + PG8_SA(b, h) + aoff + m * 2048 + k * 1024); } while (0)
#define PG8_LDB(dst, b, h) do { _Pragma("unroll") for (int n = 0; n < 2; ++n) _Pragma("unroll") for (int k = 0; k < 2; ++k) dst[n][k] = *(const PG8_LAS bf16x8*)(lds + PG8_SB(b, h) + boff + n * 2048 + k * 1024); } while (0)
#define PG8_MMA(ai, bj, At, Bt) do { __builtin_amdgcn_s_setprio(1); _Pragma("unroll") for (int m = 0; m < 4; ++m) _Pragma("unroll") for (int n = 0; n < 2; ++n) _Pragma("unroll") for (int k = 0; k < 2; ++k) \
        acc[ai][bj][m][n] = __builtin_amdgcn_mfma_f32_16x16x32_bf16(Bt[n][k], At[m][k], acc[ai][bj][m][n], 0, 0, 0); __builtin_amdgcn_s_setprio(0); } while (0)
#define PG8_WAIT_V(n) asm volatile("s_waitcnt vmcnt(" #n ")" ::: "memory")
#define PG8_WAIT_L(n) asm volatile("s_waitcnt lgkmcnt(" #n ")" ::: "memory")
#define PG8_BAR __builtin_amdgcn_s_barrier()
#define PG8_SCHED __builtin_amdgcn_sched_barrier(0)
    Unit cur, nxt; int ui = 0;
    if (!S.next(0, cur)) return;
    f32x4 acc[2][2][4][2];
#pragma unroll
    for (int a = 0; a < 2; ++a)
#pragma unroll
        for (int b = 0; b < 2; ++b)
#pragma unroll
            for (int m = 0; m < 4; ++m)
#pragma unroll
                for (int n = 0; n < 2; ++n) acc[a][b][m][n] = (f32x4){0.f, 0.f, 0.f, 0.f};
    bf16x8 At[4][2], B0[2][2], B1[2][2];
    const char* cA = (const char*)g.A + (size_t)cur.pm * tstepA + (size_t)((cur.pn & g.amask) * 512) + (size_t)cur.kt0 * kstep; const char* cB = (const char*)g.Bt + (size_t)cur.pn * tstepB + (size_t)cur.kt0 * kstep;
    S.a_ready(cur);
    if constexpr (SP2) {
        PG8_STAGE(PG8_SB(0, 0), cB, voffB); PG8_STAGE(PG8_SB(0, 1), cB + hstepB, voffB); PG8_STAGE(PG8_SA(0, 0), cA, voffA); PG8_STAGE(PG8_SA(0, 1), cA + hstepA, voffA);
        if (wr == 1) PG8_BAR;
        PG8_WAIT_V(2); PG8_BAR;
        PG8_STAGE(PG8_SB(1, 0), cB + kstep, voffB); PG8_STAGE(PG8_SA(1, 0), cA + kstep, voffA); PG8_STAGE(PG8_SB(1, 1), cB + hstepB + kstep, voffB);
        PG8_WAIT_V(6); PG8_BAR;
    } else {
        PG8_STAGE(PG8_SB(0, 0), cB, voffB); PG8_STAGE(PG8_SA(0, 0), cA, voffA); PG8_STAGE(PG8_SB(0, 1), cB + hstepB, voffB); PG8_STAGE(PG8_SA(0, 1), cA + hstepA, voffA);
        if (wr == 1) PG8_BAR;
        PG8_WAIT_V(4); PG8_BAR;
        PG8_STAGE(PG8_SB(1, 0), cB + kstep, voffB); PG8_STAGE(PG8_SA(1, 0), cA + kstep, voffA); PG8_STAGE(PG8_SB(1, 1), cB + hstepB + kstep, voffB);
        PG8_WAIT_V(6); PG8_BAR;
    }
    for (;;) {
        const bool has_next = S.next(ui + 1, nxt);
        const char* nA = has_next ? (const char*)g.A + (size_t)nxt.pm * tstepA + (size_t)((nxt.pn & g.amask) * 512) + (size_t)nxt.kt0 * kstep : cA; const char* nB = has_next ? (const char*)g.Bt + (size_t)nxt.pn * tstepB + (size_t)nxt.kt0 * kstep : cB;
        const int nt = cur.nt;
        for (int t = 0; t < nt; t += 2) {
            const bool last = (t == nt - 2);
            const char* a1 = cA + (size_t)(t + 1) * kstep;
            const char* a2 = last ? nA : cA + (size_t)(t + 2) * kstep; const char* b2 = last ? nB : cB + (size_t)(t + 2) * kstep;
            const char* a3 = a2 + kstep; const char* b3 = b2 + kstep;
            if (last && has_next) S.a_ready(nxt);
            if constexpr (SP2) {
            PG8_LDB(B0, 0, 0); PG8_LDB(B1, 0, 1); PG8_SCHED; PG8_LDA(At, 0, 0); PG8_STAGE(PG8_SA(1, 1), a1 + hstepA, voffA);
            PG8_WAIT_V(8); PG8_WAIT_L(0); PG8_BAR; PG8_MMA(0, 0, At, B0); PG8_MMA(0, 1, At, B1); PG8_BAR; PG8_SCHED;
            PG8_LDA(At, 0, 1); PG8_STAGE(PG8_SB(0, 0), b2, voffB); PG8_STAGE(PG8_SB(0, 1), b2 + hstepB, voffB); PG8_STAGE(PG8_SA(0, 0), a2, voffA);
            PG8_WAIT_V(8); PG8_WAIT_L(0); PG8_BAR; PG8_MMA(1, 0, At, B0); PG8_MMA(1, 1, At, B1); PG8_BAR; PG8_SCHED;
            PG8_LDB(B0, 1, 0); PG8_LDB(B1, 1, 1); PG8_SCHED; PG8_LDA(At, 1, 0); PG8_STAGE(PG8_SA(0, 1), a2 + hstepA, voffA);
            PG8_WAIT_V(8); PG8_WAIT_L(0); PG8_BAR; PG8_MMA(0, 0, At, B0); PG8_MMA(0, 1, At, B1); PG8_BAR; PG8_SCHED;
            PG8_LDA(At, 1, 1); PG8_STAGE(PG8_SB(1, 0), b3, voffB); PG8_STAGE(PG8_SB(1, 1), b3 + hstepB, voffB); PG8_STAGE(PG8_SA(1, 0), a3, voffA);
            PG8_WAIT_V(8); PG8_WAIT_L(0); PG8_BAR; PG8_MMA(1, 0, At, B0); PG8_MMA(1, 1, At, B1); PG8_BAR; PG8_SCHED;
            } else {
            PG8_LDB(B0, 0, 0); PG8_SCHED; PG8_LDA(At, 0, 0); PG8_STAGE(PG8_SA(1, 1), a1 + hstepA, voffA);
            PG8_WAIT_L(8); PG8_BAR; PG8_WAIT_L(0); PG8_MMA(0, 0, At, B0); PG8_BAR; PG8_SCHED;
            PG8_LDB(B1, 0, 1); PG8_STAGE(PG8_SB(0, 0), b2, voffB);
            PG8_BAR; PG8_WAIT_L(0); PG8_MMA(0, 1, At, B1); PG8_BAR;
            PG8_LDA(At, 0, 1); PG8_STAGE(PG8_SA(0, 0), a2, voffA);
            PG8_BAR; PG8_WAIT_L(0); PG8_MMA(1, 0, At, B0); PG8_BAR; PG8_SCHED;
            PG8_STAGE(PG8_SB(0, 1), b2 + hstepB, voffB);
            PG8_WAIT_V(6); PG8_BAR; PG8_MMA(1, 1, At, B1); PG8_BAR;
            PG8_LDB(B0, 1, 0); PG8_SCHED; PG8_LDA(At, 1, 0); PG8_STAGE(PG8_SA(0, 1), a2 + hstepA, voffA);
            PG8_WAIT_L(8); PG8_BAR; PG8_WAIT_L(0); PG8_MMA(0, 0, At, B0); PG8_BAR; PG8_SCHED;
            PG8_LDB(B1, 1, 1); PG8_STAGE(PG8_SB(1, 0), b3, voffB);
            PG8_BAR; PG8_WAIT_L(0); PG8_MMA(0, 1, At, B1); PG8_BAR;
            PG8_LDA(At, 1, 1); PG8_STAGE(PG8_SA(1, 0), a3, voffA);
            PG8_BAR; PG8_WAIT_L(0); PG8_MMA(1, 0, At, B0); PG8_BAR; PG8_SCHED;
            PG8_STAGE(PG8_SB(1, 1), b3 + hstepB, voffB);
            PG8_WAIT_V(6); PG8_BAR; PG8_MMA(1, 1, At, B1); PG8_BAR;
            }
        }
        if constexpr (ALIGN_EPI) { if (wr == 0) PG8_BAR; }
        if constexpr (!Epi::AFTER_DRAIN) { E(acc, cur, wr, wc, fr, fq); S.done(cur); }
        if (!has_next) break;
#pragma unroll
        for (int a = 0; a < 2; ++a)
#pragma unroll
            for (int b = 0; b < 2; ++b)
#pragma unroll
                for (int m = 0; m < 4; ++m)
#pragma unroll
                    for (int n = 0; n < 2; ++n) acc[a][b][m][n] = (f32x4){0.f, 0.f, 0.f, 0.f};
        cur = nxt; cA = nA; cB = nB; ++ui;
        if constexpr (ALIGN_EPI) { if (wr == 1) PG8_BAR; }
    }
    PG8_WAIT_V(0);
    if constexpr (!ALIGN_EPI) { if (wr == 0) PG8_BAR; }
    PG8_BAR;
    if constexpr (Epi::AFTER_DRAIN) { E.fused(acc, cur, wr, wc, fr, fq, lds, wid, lane); S.done(cur); }
#undef PG8_SA
#undef PG8_SB
#undef PG8_STAGE
#undef PG8_LDA
#undef PG8_LDB
#undef PG8_MMA
#undef PG8_WAIT_V
#undef PG8_WAIT_L
#undef PG8_BAR
#undef PG8_SCHED
}
}

#ifndef REP_RWSCAN
#define REP_RWSCAN 1
#endif
constexpr int DM = 2048, NPB = 4, SEQ = 2048, NDB = 128, DSEQ = 8;
constexpr int MP = NPB * SEQ, MS = NDB * DSEQ, M = MP + MS, NSEQ = NPB + NDB;
constexpr int DINE = 7424, DINO = 6144, DRP = 3328, DFF = 5632;
constexpr float RMS_EPS = 1e-6f, GN_EPS = 64e-5f;
constexpr int NWAVES = 8, NTHR = 512;

constexpr size_t SZ_HGRN = 8 * 128 * 128, SZ_RWKV = 16 * 64 * 64, SZ_RET = 4 * 256 * 256, SZ_CONV = 3 * 1024;
constexpr size_t O_HGRN_P = (size_t)M * DM;
constexpr size_t O_HGRN_S = O_HGRN_P + 2 * NPB * SZ_HGRN;
constexpr size_t O_RWKV_P = O_HGRN_S + 2 * NDB * SZ_HGRN;
constexpr size_t O_RWKV_S = O_RWKV_P + 2 * NPB * SZ_RWKV;
constexpr size_t O_SHIFT_P = O_RWKV_S + 2 * NDB * SZ_RWKV;
constexpr size_t O_SHIFT_S = O_SHIFT_P + 2 * NPB * DRP;
constexpr size_t O_RET_P = O_SHIFT_S + 2 * NDB * DRP;
constexpr size_t O_RET_S = O_RET_P + 2 * NPB * SZ_RET;
constexpr size_t O_CONV_P = O_RET_S + 2 * NDB * SZ_RET;
constexpr size_t O_CONV_S = O_CONV_P + 2 * NPB * SZ_CONV;
constexpr size_t O_H_P = O_CONV_S + 2 * NDB * SZ_CONV;
constexpr size_t O_H_S = O_H_P + 2 * NPB * 1024;
constexpr size_t O_END = O_H_S + 2 * NDB * 1024;
static_assert(O_END == 141944832ull, "output size");

constexpr size_t WS_CTL = 0, CTL_BYTES = 1u << 20;
constexpr size_t WS_WIE = CTL_BYTES;
constexpr size_t WS_WOE = WS_WIE + 2ull * DINE * DM * 2;
constexpr size_t WS_WIO = WS_WOE + 2ull * DM * DM * 2;
constexpr size_t WS_WOO = WS_WIO + 2ull * DINO * DM * 2;
constexpr size_t WS_WFI = WS_WOO + 2ull * DM * DM * 2;
constexpr size_t WS_WFO = WS_WFI + 4ull * 2 * DFF * DM * 2;
constexpr size_t WS_WLR = WS_WFO + 4ull * DM * DFF * 2;
constexpr size_t WS_WGT = WS_WLR + 2ull * 3072 * 256 * 2;
constexpr size_t WS_BLR = WS_WGT + 2ull * 2048 * 256 * 2;
constexpr size_t WS_BGT = WS_BLR + 2ull * 3072 * 4;
constexpr size_t WS_ROT = WS_BGT + 2ull * 2048 * 4;
constexpr size_t WS_HN = WS_ROT + 2056ull * 128 * 8;
constexpr size_t WS_Z = WS_HN + (size_t)M * DM * 2;
constexpr size_t WS_O = WS_Z + (size_t)M * DINE * 2;
constexpr size_t WS_MIX = WS_O + (size_t)M * DM * 2;
constexpr size_t WS_ACT = WS_MIX + (size_t)M * DM * 4;
constexpr size_t WS_SA = WS_ACT + (size_t)M * DFF * 2;
constexpr size_t WS_SG = WS_SA + (size_t)M * 1024 * 2;
constexpr size_t WS_ORAW = WS_SG + (size_t)M * 3072 * 4;
constexpr size_t WS_YRAW = WS_ORAW + (size_t)M * 1024 * 4;
constexpr size_t WS_RK = WS_YRAW + (size_t)M * 1024 * 4;
constexpr size_t WS_PART = WS_RK + (size_t)M * 16 * 4;
constexpr size_t WS_END = WS_PART + 8ull * MS * DM * 4;
static_assert(WS_HN % 256 == 0 && WS_Z % 256 == 0 && WS_SG % 256 == 0, "alignment");
constexpr int CW_BAR = 4096;

constexpr int RING_OFF = 0, RING_BYTES = 131072;
constexpr int LDSCTL_OFF = RING_BYTES, MISC_OFF = LDSCTL_OFF + 320;
constexpr int LDS_BYTES = 147456;

#define GAS __attribute__((address_space(1)))
#define LAS __attribute__((address_space(3)))
typedef unsigned short bf16;
typedef unsigned v4u __attribute__((ext_vector_type(4)));
typedef unsigned v2u __attribute__((ext_vector_type(2)));
typedef float f32x4 __attribute__((ext_vector_type(4)));
typedef float f32x2 __attribute__((ext_vector_type(2)));
#define LDS_WAIT() asm volatile("s_waitcnt lgkmcnt(0)" ::: "memory")
#define LBAR() do { asm volatile("s_waitcnt lgkmcnt(0)" ::: "memory"); __builtin_amdgcn_s_barrier(); asm volatile("" ::: "memory"); } while (0)
__device__ __forceinline__ unsigned f2bf(float f) { unsigned u = __builtin_bit_cast(unsigned, f); return (u + 0x7fffu + ((u >> 16) & 1u)) >> 16; }
__device__ __forceinline__ unsigned pk2(float lo, float hi) { return f2bf(lo) | (f2bf(hi) << 16); }
__device__ __forceinline__ float bf2f(bf16 b) { return __uint_as_float((unsigned)b << 16); }
__device__ __forceinline__ float bflo(unsigned w) { return __uint_as_float(w << 16); }
__device__ __forceinline__ float bfhi(unsigned w) { return __uint_as_float(w & 0xffff0000u); }
__device__ __forceinline__ void unpack8(const v4u w, float (&f)[8]) { f[0] = bflo(w.x); f[1] = bfhi(w.x); f[2] = bflo(w.y); f[3] = bfhi(w.y); f[4] = bflo(w.z); f[5] = bfhi(w.z); f[6] = bflo(w.w); f[7] = bfhi(w.w); }
__device__ __forceinline__ v4u pack8(const float (&f)[8]) { v4u w; w.x = pk2(f[0], f[1]); w.y = pk2(f[2], f[3]); w.z = pk2(f[4], f[5]); w.w = pk2(f[6], f[7]); return w; }
__device__ __forceinline__ float sigm(float x) { return 1.0f / (1.0f + __expf(-x)); }
__device__ __forceinline__ float siluf(float x) { return x * sigm(x); }
template <int CTRL> __device__ __forceinline__ float dpp(float x) { return __builtin_bit_cast(float, __builtin_amdgcn_update_dpp(0, __builtin_bit_cast(int, x), CTRL, 0xF, 0xF, true)); }
__device__ __forceinline__ float quad_sum(float x) { x += dpp<0xB1>(x); x += dpp<0x4E>(x); return x; }
__device__ __forceinline__ float oct_sum(float x) { x = quad_sum(x); x += dpp<0x141>(x); return x; }
__device__ __forceinline__ float row16_sum(float x) { x = oct_sum(x); x += dpp<0x140>(x); return x; }
__device__ __forceinline__ float wave_sum(float v) {
#pragma unroll
    for (int o = 1; o < 64; o <<= 1) v += __shfl_xor(v, o);
    return v;
}
__device__ __forceinline__ int seq_T(int s) { return s < NPB ? SEQ : DSEQ; }
__device__ __forceinline__ int seq_row0(int s) { return s < NPB ? s * SEQ : MP + (s - NPB) * DSEQ; }
__device__ __forceinline__ void row_ts(int row, int& t, int& s) { if (row < MP) { t = row & (SEQ - 1); s = row >> 11; } else { const int r2 = row - MP; t = r2 & (DSEQ - 1); s = NPB + (r2 >> 3); } }
__device__ __forceinline__ float* st_out_ptr(float* out, size_t base_p, size_t base_s, size_t per, int j, int s) {
    return s < NPB ? out + base_p + ((size_t)j * NPB + s) * per : out + base_s + ((size_t)j * NDB + (s - NPB)) * per; }

#define XB_TMO      128
#define XB_XCNT(j)  (256  + 64 * (j))
#define XB_XSUB(j)  (1280 + 64 * (j))
#define XB_XGEN(j)  (2304 + 64 * (j))
#define XB_TOP      3328
#define XB_TOPGEN   3392
#define XCD_BAR_WORDS 3456
#define XB_SPIN_CAP (1u << 18)

__device__ __forceinline__ unsigned xb_ld(unsigned* p)              { return __hip_atomic_load(p, __ATOMIC_RELAXED, __HIP_MEMORY_SCOPE_AGENT); }
__device__ __forceinline__ unsigned xb_add(unsigned* p, unsigned v) { return __hip_atomic_fetch_add(p, v, __ATOMIC_RELAXED, __HIP_MEMORY_SCOPE_AGENT); }
__device__ __forceinline__ unsigned xb_xcc_id() { return (unsigned)__builtin_amdgcn_s_getreg((3 << 11) | 20) & 0xFu; }
#define XB_SPIN(cond, bar) do { unsigned _sp = 0; while (cond) { __builtin_amdgcn_s_sleep(1); \
    if ((++_sp & 255u) == 0u) { if (xb_ld(&(bar)[XB_TMO])) break; if (_sp > XB_SPIN_CAP) { atomicAdd(&(bar)[XB_TMO], 1u); break; } } } } while (0)

struct XcdBarrier {
    unsigned* bar; unsigned x;
    volatile LAS unsigned* st;
};

__device__ __forceinline__ XcdBarrier xcd_barrier_post(unsigned* bar, volatile LAS unsigned* st) {
    XcdBarrier b; b.bar = bar; b.x = xb_xcc_id(); b.st = st;
    if (threadIdx.x == 0) (void)xb_add(&bar[XB_XCNT(b.x)], 1u);
    return b;
}
__device__ __forceinline__ void xcd_barrier_complete(unsigned* bar, unsigned x, unsigned& nloc, unsigned& nx) {
    const unsigned G = gridDim.x * gridDim.y * gridDim.z;
    unsigned sum, cnt, mine, sp = 0u;
    for (;;) {
        sum = 0u; cnt = 0u; mine = 0u;
#pragma unroll
        for (unsigned j = 0; j < 16; ++j) { const unsigned c = xb_ld(&bar[XB_XCNT(j)]); sum += c; cnt += (c > 0u) ? 1u : 0u; mine = (j == x) ? c : mine; }
        if (sum == G) break;
        __builtin_amdgcn_s_sleep(1);
        if ((++sp & 255u) == 0u) { if (xb_ld(&bar[XB_TMO])) break; if (sp > XB_SPIN_CAP) { atomicAdd(&bar[XB_TMO], 1u); break; } }
    }
    nloc = mine > 0u ? mine : 1u; nx = cnt > 0u ? cnt : 1u;
}

__device__ __forceinline__ void xcd_barrier(const XcdBarrier& b) {
    asm volatile("s_waitcnt vmcnt(0)" ::: "memory");
    __syncthreads();
    if (threadIdx.x == 0) {
        unsigned* bar = b.bar;
        __builtin_amdgcn_s_waitcnt(0);
        unsigned nloc = b.st[0], nx = b.st[1];
        if (nloc == 0u) { xcd_barrier_complete(bar, b.x, nloc, nx); b.st[0] = nloc; b.st[1] = nx; }
        const unsigned old = xb_add(&bar[XB_XSUB(b.x)], 1u);
        const unsigned gen = old / nloc;
        if (old + 1u == (gen + 1u) * nloc) {
            __builtin_amdgcn_fence(__ATOMIC_RELEASE, "agent");
            asm volatile("s_waitcnt vmcnt(0)" ::: "memory");
            const unsigned og = xb_add(&bar[XB_TOP], 1u);
            const unsigned tg = og / nx;
            if (og + 1u == (tg + 1u) * nx) xb_add(&bar[XB_TOPGEN], 1u);
            else XB_SPIN(xb_ld(&bar[XB_TOPGEN]) == tg, bar);
            __builtin_amdgcn_fence(__ATOMIC_ACQUIRE, "agent");
            xb_add(&bar[XB_XGEN(b.x)], 1u);
            asm volatile("s_waitcnt vmcnt(0)" ::: "memory");
        } else {
            XB_SPIN(xb_ld(&bar[XB_XGEN(b.x)]) == gen, bar);
            __builtin_amdgcn_fence(__ATOMIC_ACQUIRE, "agent");
            asm volatile("s_waitcnt vmcnt(0)" ::: "memory");
        }
    }
    __syncthreads();
}


__device__ __forceinline__ void p0_transpose_item(const float* W, int K, int N, bf16* WT, int mode, LAS unsigned char* scr, int item, int lane) {
    const int nblk = N / 64, kb = item / nblk, nb = item - kb * nblk, k0 = 64 * kb, n0 = 64 * nb;
    const GAS float* src = (const GAS float*)W + (size_t)(k0 + (lane >> 4) * 16) * N + n0 + (lane & 15) * 4;
    f32x4 v[16];
#pragma unroll
    for (int i = 0; i < 16; ++i) v[i] = *(const GAS f32x4*)(src + (size_t)i * N);
#pragma unroll
    for (int e = 0; e < 4; ++e) {
        v4u a, b; a.x = pk2(v[0][e], v[1][e]); a.y = pk2(v[2][e], v[3][e]); a.z = pk2(v[4][e], v[5][e]); a.w = pk2(v[6][e], v[7][e]);
        b.x = pk2(v[8][e], v[9][e]); b.y = pk2(v[10][e], v[11][e]); b.z = pk2(v[12][e], v[13][e]); b.w = pk2(v[14][e], v[15][e]);
        LAS unsigned char* p = scr + ((lane & 15) * 4 + e) * 144 + (lane >> 4) * 32;
        *(LAS v4u*)p = a; *(LAS v4u*)(p + 16) = b;
    }
    LDS_WAIT();
    int nrow0 = n0;
    if (mode == 1) { const int up = n0 >= DFF ? 1 : 0, c = n0 - up * DFF; nrow0 = (c >> 7) * 256 + (c & 127) + up * 128; }
#pragma unroll
    for (int jj = 0; jj < 8; ++jj) { const int n = (lane >> 3) + 8 * jj;
        const v4u o = *(const LAS v4u*)(scr + n * 144 + (lane & 7) * 16);
        *(GAS v4u*)((GAS bf16*)WT + (size_t)(nrow0 + n) * K + k0 + (lane & 7) * 8) = o; }
    LDS_WAIT();
}

template <bool HAS_MIX, bool HAS_HN>
__device__ __forceinline__ void norm_row(const float* xin, const float* mix, float* xout, const float* wpost, const float* wpre, bf16* hn, int lane, int nparts = 1, size_t pstride = 0) {
    const GAS f32x4* xr = (const GAS f32x4*)xin + lane;
    f32x4 x[8];
#pragma unroll
    for (int jj = 0; jj < 8; ++jj) x[jj] = xr[64 * jj];
    if (HAS_MIX) {
        const GAS f32x4* mr = (const GAS f32x4*)mix + lane; const GAS f32x4* wp = (const GAS f32x4*)wpost + lane;
        f32x4 m[8]; float s = 0.f;
#pragma unroll
        for (int jj = 0; jj < 8; ++jj) m[jj] = mr[64 * jj];
        for (int p = 1; p < nparts; ++p) {
            const GAS f32x4* pr = (const GAS f32x4*)(mix + (size_t)p * pstride) + lane;
#pragma unroll
            for (int jj = 0; jj < 8; ++jj) m[jj] = m[jj] + pr[64 * jj]; }
#pragma unroll
        for (int jj = 0; jj < 8; ++jj) s += (m[jj].x * m[jj].x + m[jj].y * m[jj].y) + (m[jj].z * m[jj].z + m[jj].w * m[jj].w);
        const float rs = rsqrtf(wave_sum(s) * (1.0f / DM) + RMS_EPS);
#pragma unroll
        for (int jj = 0; jj < 8; ++jj) { const f32x4 w = wp[64 * jj]; x[jj] = x[jj] + m[jj] * rs * w; }
    }
    GAS f32x4* xo = (GAS f32x4*)xout + lane;
#pragma unroll
    for (int jj = 0; jj < 8; ++jj) xo[64 * jj] = x[jj];
    if (HAS_HN) {
        float s = 0.f;
#pragma unroll
        for (int jj = 0; jj < 8; ++jj) s += (x[jj].x * x[jj].x + x[jj].y * x[jj].y) + (x[jj].z * x[jj].z + x[jj].w * x[jj].w);
        const float rs = rsqrtf(wave_sum(s) * (1.0f / DM) + RMS_EPS);
        const GAS f32x4* wq = (const GAS f32x4*)wpre + lane; GAS v2u* ho = (GAS v2u*)hn + lane;
#pragma unroll
        for (int jj = 0; jj < 8; ++jj) { const f32x4 w = wq[64 * jj]; const f32x4 y = x[jj] * rs * w; v2u o; o.x = pk2(y.x, y.y); o.y = pk2(y.z, y.w); ho[64 * jj] = o; }
    }
}

template <int N> __device__ __forceinline__ void lds_vec(const LAS float* p, float (&o)[N]) {
    if constexpr (N == 2) { const f32x2 v = *(const LAS f32x2*)p; o[0] = v.x; o[1] = v.y; }
    else {
#pragma unroll
        for (int i = 0; i < N / 4; ++i) { const f32x4 v = *(const LAS f32x4*)(p + 4 * i); o[4 * i] = v.x; o[4 * i + 1] = v.y; o[4 * i + 2] = v.z; o[4 * i + 3] = v.w; } }
}
template <int CPL>
__device__ __forceinline__ void hgrn_unit(LAS float* L, const bf16* Z, int j, int s, int h, int vs, const float* st_in, float* st_out, float* ORAW, const float* lbraw, int tid) {
    constexpr int TB = CPL == 1 ? 16 : 8, NV = 16 * CPL, NVG = NV / 8, NG = TB * NVG, BUF = TB * (3 * 128 + NV), OPB = 8 * TB * NV;
    LAS float* Q = L; LAS float* K = Q + TB * 128; LAS float* F = K + TB * 128; LAS float* V = F + TB * 128; LAS float* OP = L + 2 * BUF; LAS float* DUM = OP + 2 * OPB;
    const int T = seq_T(s), row0 = seq_row0(s);
    const int w = tid >> 6, lane = tid & 63, vl = lane >> 2, dl = lane & 3, dk0 = 16 * w + 4 * dl;
    const int vcol0 = vs * NV + vl * CPL;
    f32x2 S0[CPL], S1[CPL];
#pragma unroll
    for (int c = 0; c < CPL; ++c) { S0[c] = (f32x2){0.f, 0.f}; S1[c] = S0[c];
        if (st_in) { S0[c].x = st_in[(size_t)(dk0 + 0) * 128 + vcol0 + c]; S0[c].y = st_in[(size_t)(dk0 + 1) * 128 + vcol0 + c]; S1[c].x = st_in[(size_t)(dk0 + 2) * 128 + vcol0 + c]; S1[c].y = st_in[(size_t)(dk0 + 3) * 128 + vcol0 + c]; } }
    const int ptt = tid >> 4, pd8 = (tid & 15) * 8; const bool pact = ptt < TB;
    const int gtt = tid / NVG, gc8 = (tid % NVG) * 8; const bool gact = tid < NG;
    float lb[8];
#pragma unroll
    for (int e = 0; e < 8; ++e) lb[e] = (j == 0) ? 0.f : sigm(lbraw[1024 + h * 128 + pd8 + e] - lbraw[h * 128 + pd8 + e]);
    v4u rq = (v4u){0u, 0u, 0u, 0u}, rf = rq, rv = rq;
#define HG_LOAD(t0_) do { if (pact) { const bf16* zr_ = Z + (size_t)(row0 + (t0_) + ptt) * DINE + h * 128 + pd8; rq = *(const GAS v4u*)zr_; rf = *(const GAS v4u*)(zr_ + 1024); } \
        if (gact) rv = *(const GAS v4u*)(Z + (size_t)(row0 + (t0_) + gtt) * DINE + 2048 + h * 128 + vs * NV + gc8); } while (0)
#define HG_RD(q_, k_, f_, v_, tt_) do { q_ = *(const LAS f32x4*)(Q + bo + (tt_) * 128 + dk0); k_ = *(const LAS f32x4*)(K + bo + (tt_) * 128 + dk0); f_ = *(const LAS f32x4*)(F + bo + (tt_) * 128 + dk0); \
        if constexpr (CPL == 1) v_[0] = vreg[(tt_)]; else lds_vec<CPL>(V + bo + (tt_) * NV + vl * CPL, v_); __builtin_amdgcn_sched_barrier(0); } while (0)
#define HG_STEP(q_, k_, f_, v_, tt_) do { _Pragma("unroll") for (int c = 0; c < CPL; ++c) { const f32x2 vb_ = (f32x2){v_[c], v_[c]}; \
            S0[c] = (f32x2){f_.x, f_.y} * S0[c] + (f32x2){k_.x, k_.y} * vb_; S1[c] = (f32x2){f_.z, f_.w} * S1[c] + (f32x2){k_.z, k_.w} * vb_; \
            const f32x2 t_ = S0[c] * (f32x2){q_.x, q_.y} + S1[c] * (f32x2){q_.z, q_.w}; const float o_ = quad_sum(t_.x + t_.y); \
            if constexpr (CPL == 1) { okeep[(tt_) & 3] = (dl == ((tt_) >> 2)) ? o_ : okeep[(tt_) & 3]; } else opw[(tt_) * NV + c] = o_; } } while (0)
#define HG_XFORM(bo_) do { if (pact) { \
            float zq[8], zf[8]; unpack8(rq, zq); unpack8(rf, zf); float q[8], k[8], f[8]; \
            _Pragma("unroll") for (int e = 0; e < 8; ++e) { q[e] = siluf(zq[e]); const float ex = __expf(-zf[e]); const float sg = 1.0f / (1.0f + ex); f[e] = lb[e] + (1.0f - lb[e]) * sg; k[e] = (1.0f - lb[e]) * (ex < 1e30f ? ex * sg : 1.0f); } \
            LAS f32x4* qd = (LAS f32x4*)(Q + (bo_) + ptt * 128 + pd8); LAS f32x4* kd = (LAS f32x4*)(K + (bo_) + ptt * 128 + pd8); LAS f32x4* fd = (LAS f32x4*)(F + (bo_) + ptt * 128 + pd8); \
            qd[0] = (f32x4){q[0], q[1], q[2], q[3]}; qd[1] = (f32x4){q[4], q[5], q[6], q[7]}; kd[0] = (f32x4){k[0], k[1], k[2], k[3]}; kd[1] = (f32x4){k[4], k[5], k[6], k[7]}; \
            fd[0] = (f32x4){f[0], f[1], f[2], f[3]}; fd[1] = (f32x4){f[4], f[5], f[6], f[7]}; } \
        if (gact) { float v8[8]; unpack8(rv, v8); \
            if constexpr (CPL == 1) { _Pragma("unroll") for (int e = 0; e < 8; ++e) V[(bo_) + (gc8 + e) * TB + gtt] = v8[e]; }     \
            else { LAS f32x4* vd = (LAS f32x4*)(V + (bo_) + gtt * NV + gc8); vd[0] = (f32x4){v8[0], v8[1], v8[2], v8[3]}; vd[1] = (f32x4){v8[4], v8[5], v8[6], v8[7]}; } } } while (0)
    HG_LOAD(0);
    HG_XFORM(0);
    LBAR();
    for (int t0 = 0, pb = 0; t0 < T; t0 += TB, pb ^= 1) {
        const int bo = pb * BUF, oo = pb * OPB; const bool more = t0 + TB < T;
        LAS float* opw = (dl == 0) ? OP + oo + w * TB * NV + vl * CPL : DUM + lane;
        if (more) HG_LOAD(t0 + TB);
        {
            f32x4 qa, ka, fa, qb, kb, fb; float va[CPL], vb[CPL]; float vreg[16]; f32x4 okeep = (f32x4){0.f, 0.f, 0.f, 0.f};
            if constexpr (CPL == 1) lds_vec<16>(V + bo + vl * TB, vreg);
            HG_RD(qa, ka, fa, va, 0);
#pragma unroll
            for (int tt = 0; tt < TB; tt += 2) {
                HG_RD(qb, kb, fb, vb, tt + 1);
                HG_STEP(qa, ka, fa, va, tt);
                if (tt + 2 < TB) HG_RD(qa, ka, fa, va, tt + 2);
                HG_STEP(qb, kb, fb, vb, tt + 1);
            }
            if constexpr (CPL == 1) *(LAS f32x4*)(OP + oo + (w * 16 + vl) * TB + 4 * dl) = okeep;
        }
        if (more) HG_XFORM((pb ^ 1) * BUF);
        LBAR();
        for (int idx = tid; idx < TB * NV; idx += NTHR) { const int tt = idx / NV, c = idx - tt * NV; float o = 0.f;
#pragma unroll
            for (int ww = 0; ww < 8; ++ww) o += (CPL == 1) ? OP[oo + (ww * 16 + c) * TB + tt] : OP[oo + (ww * TB + tt) * NV + c];
            ORAW[(size_t)(row0 + t0 + tt) * 1024 + h * 128 + vs * NV + c] = o; }
    }
#undef HG_XFORM
#undef HG_LOAD
#undef HG_RD
#undef HG_STEP
#pragma unroll
    for (int c = 0; c < CPL; ++c) { st_out[(size_t)(dk0 + 0) * 128 + vcol0 + c] = S0[c].x; st_out[(size_t)(dk0 + 1) * 128 + vcol0 + c] = S0[c].y; st_out[(size_t)(dk0 + 2) * 128 + vcol0 + c] = S1[c].x; st_out[(size_t)(dk0 + 3) * 128 + vcol0 + c] = S1[c].y; }
    LBAR();
}

struct RwkvP { const float *mu, *kk, *ka, *rk; };
template <int RPL>
__device__ __forceinline__ void rwkv_unit(LAS float* L, const bf16* Z, const float* SG, const RwkvP P, int s, int h, int rbase, bool write_rk, const float* st_shift, const float* st_in, float* st_out, float* YRAW, float* RK, int tid) {
    constexpr int TB = RPL == 1 ? 16 : 8, NR = 16 * RPL, BUF = TB * (5 * 64 + NR + 2), YB = TB * NR;
    LAS float* Wd = L; LAS float* KK = Wd + TB * 64; LAS float* KA = KK + TB * 64; LAS float* KB = KA + TB * 64; LAS float* R = KB + TB * 64; LAS float* Vv = R + TB * 64; LAS float* C12 = Vv + TB * NR; LAS float* Yo = L + 2 * BUF; LAS float* DUM = Yo + 2 * YB;
    const int T = seq_T(s), row0 = seq_row0(s);
    const int il = tid >> 4, jp = tid & 15;
    f32x2 S01[RPL], S23[RPL];
#pragma unroll
    for (int rr = 0; rr < RPL; ++rr) { S01[rr] = (f32x2){0.f, 0.f}; S23[rr] = S01[rr]; }
    if (tid < 256 && st_in) {
#pragma unroll
        for (int rr = 0; rr < RPL; ++rr) { const f32x4 v = *(const GAS f32x4*)(st_in + (size_t)(rbase + il + 16 * rr) * 64 + 4 * jp); S01[rr] = (f32x2){v.x, v.y}; S23[rr] = (f32x2){v.z, v.w}; }
    }
    const int ptt = tid >> 4, part = tid & 15, col4 = h * 64 + 4 * part; const bool pact = ptt < TB;
    const f32x4 mu_r = *(const GAS f32x4*)(P.mu + col4), mu_k = *(const GAS f32x4*)(P.mu + 1024 + col4), mu_v = *(const GAS f32x4*)(P.mu + 2048 + col4);
    const f32x4 c_kk = *(const GAS f32x4*)(P.kk + col4), c_ka = *(const GAS f32x4*)(P.ka + col4), c_rk = *(const GAS f32x4*)(P.rk + col4);
    v2u zr = (v2u){0u, 0u}, zk = zr, zv = zr, yr = zr, yk = zr, yv = zr; f32x4 fr = (f32x4){0.f, 0.f, 0.f, 0.f}, fk = fr, fv = fr, wp = fr, ap = fr; bool prevf = false;
#define RW_LOAD(t0_) do { if (pact) { const int t_ = (t0_) + ptt; const size_t row_ = (size_t)(row0 + t_); const bf16* zb_ = Z + row_ * DINE + 4096 + col4; \
            zr = *(const GAS v2u*)zb_; zk = *(const GAS v2u*)(zb_ + 1024); zv = *(const GAS v2u*)(zb_ + 2048); prevf = false; \
            if (t_ > 0) { yr = *(const GAS v2u*)(zb_ - DINE); yk = *(const GAS v2u*)(zb_ + 1024 - DINE); yv = *(const GAS v2u*)(zb_ + 2048 - DINE); } \
            else { prevf = true; if (st_shift) { fr = *(const GAS f32x4*)(st_shift + col4); fk = *(const GAS f32x4*)(st_shift + 1024 + col4); fv = *(const GAS f32x4*)(st_shift + 2048 + col4); } \
                   else { fr = (f32x4){0.f, 0.f, 0.f, 0.f}; fk = fr; fv = fr; } } \
            wp = *(const GAS f32x4*)(SG + row_ * 3072 + col4); ap = *(const GAS f32x4*)(SG + row_ * 3072 + 1024 + col4); } } while (0)
#define RW_RD(w_, kk_, ka_, kb_, r_, v_, c_, tt_) do { const int o_ = bo + (tt_) * 64 + 4 * jp; w_ = *(const LAS f32x4*)(Wd + o_); kk_ = *(const LAS f32x4*)(KK + o_); ka_ = *(const LAS f32x4*)(KA + o_); kb_ = *(const LAS f32x4*)(KB + o_); r_ = *(const LAS f32x4*)(R + o_); \
        c_ = *(const LAS f32x2*)(C12 + bo + (tt_) * 2); \
        _Pragma("unroll") for (int rr = 0; rr < RPL; ++rr) v_[rr] = Vv[bo + (tt_) * NR + il + 16 * rr]; __builtin_amdgcn_sched_barrier(0); } while (0)
#define RW_STEP(w_, kk_, ka_, kb_, r_, v_, c_, tt_) do { _Pragma("unroll") for (int rr = 0; rr < RPL; ++rr) { \
            const f32x2 p_ = S01[rr] * (f32x2){kk_.x, kk_.y} + S23[rr] * (f32x2){kk_.z, kk_.w}; const f32x2 q_ = S01[rr] * (f32x2){r_.x, r_.y} + S23[rr] * (f32x2){r_.z, r_.w}; \
            const f32x2 vb_ = (f32x2){v_[rr], v_[rr]}; \
            const f32x2 u01_ = S01[rr] * (f32x2){w_.x, w_.y} + vb_ * (f32x2){kb_.x, kb_.y}, u23_ = S23[rr] * (f32x2){w_.z, w_.w} + vb_ * (f32x2){kb_.z, kb_.w}; \
            const float sa_ = -row16_sum(p_.x + p_.y); const float qs_ = row16_sum(q_.x + q_.y); const f32x2 sb_ = (f32x2){sa_, sa_}; \
            S01[rr] = u01_ + sb_ * (f32x2){ka_.x, ka_.y}; S23[rr] = u23_ + sb_ * (f32x2){ka_.z, ka_.w}; \
            yw[(tt_) * NR + 16 * rr] = qs_ + sa_ * c_.x + v_[rr] * c_.y; } } while (0)
#define RW_XFORM(bo_, t0_) do { if (pact) { \
            const f32x4 r0 = (f32x4){bflo(zr.x), bfhi(zr.x), bflo(zr.y), bfhi(zr.y)}, k0 = (f32x4){bflo(zk.x), bfhi(zk.x), bflo(zk.y), bfhi(zk.y)}, v0 = (f32x4){bflo(zv.x), bfhi(zv.x), bflo(zv.y), bfhi(zv.y)}; \
            f32x4 pr = fr, pk = fk, pv = fv; \
            if (!prevf) { pr = (f32x4){bflo(yr.x), bfhi(yr.x), bflo(yr.y), bfhi(yr.y)}; pk = (f32x4){bflo(yk.x), bfhi(yk.x), bflo(yk.y), bfhi(yk.y)}; pv = (f32x4){bflo(yv.x), bfhi(yv.x), bflo(yv.y), bfhi(yv.y)}; } \
            const f32x4 r = r0 + (pr - r0) * mu_r, kb = k0 + (pk - k0) * mu_k, v = v0 + (pv - v0) * mu_v; \
            f32x4 wd, a; \
            _Pragma("unroll") for (int e = 0; e < 4; ++e) { wd[e] = __expf(-0.6065306597f * sigm(wp[e])); a[e] = sigm(ap[e]); } \
            f32x4 kk = kb * c_kk; const float n2 = row16_sum((kk.x * kk.x + kk.y * kk.y) + (kk.z * kk.z + kk.w * kk.w)); \
            kk = kk * (1.0f / fmaxf(sqrtf(n2), 1e-12f)); \
            const f32x4 kbm = kb * (1.0f + (a - 1.0f) * c_ka); \
            const f32x4 rkv = r * kbm * c_rk; const float rk = row16_sum((rkv.x + rkv.y) + (rkv.z + rkv.w)); \
            const f32x4 kav = kk * a; const f32x4 e1 = kav * r, e2 = kbm * r; const float c1 = row16_sum((e1.x + e1.y) + (e1.z + e1.w)), c2 = row16_sum((e2.x + e2.y) + (e2.z + e2.w)); \
            const int o_ = (bo_) + ptt * 64 + 4 * part; \
            *(LAS f32x4*)(Wd + o_) = wd; *(LAS f32x4*)(KK + o_) = kk; *(LAS f32x4*)(KA + o_) = kav; *(LAS f32x4*)(KB + o_) = kbm; *(LAS f32x4*)(R + o_) = r * wd; if (part == 0) *(LAS f32x2*)(C12 + (bo_) + ptt * 2) = (f32x2){c1, c2}; \
            if (4 * part >= rbase && 4 * part < rbase + NR) *(LAS f32x4*)(Vv + (bo_) + ptt * NR + 4 * part - rbase) = v; \
            if (write_rk && part == 0) RK[(size_t)(row0 + (t0_) + ptt) * 16 + h] = rk; } } while (0)
    RW_LOAD(0);
    RW_XFORM(0, 0);
    LBAR();
    for (int t0 = 0, pb = 0; t0 < T; t0 += TB, pb ^= 1) {
        const int bo = pb * BUF, oo = pb * YB; const bool more = t0 + TB < T;
        LAS float* yw = (jp == 0) ? Yo + oo + il : DUM + (tid & 255);
        if (more) RW_LOAD(t0 + TB);
        if (tid < 256) {
            f32x4 wa, kka, kaa, kba, ra, wb, kkb, kab, kbb, rb; f32x2 ca, cb; float va[RPL], vb[RPL];
            RW_RD(wa, kka, kaa, kba, ra, va, ca, 0);
#pragma unroll
            for (int tt = 0; tt < TB; tt += 2) {
                RW_RD(wb, kkb, kab, kbb, rb, vb, cb, tt + 1);
                RW_STEP(wa, kka, kaa, kba, ra, va, ca, tt);
                if (tt + 2 < TB) RW_RD(wa, kka, kaa, kba, ra, va, ca, tt + 2);
                RW_STEP(wb, kkb, kab, kbb, rb, vb, cb, tt + 1);
            }
        }
        if (more) RW_XFORM((pb ^ 1) * BUF, t0 + TB);
        LBAR();
        for (int idx = tid; idx < TB * NR; idx += NTHR) { const int tt = idx / NR, i = idx - tt * NR; YRAW[(size_t)(row0 + t0 + tt) * 1024 + h * 64 + rbase + i] = Yo[oo + idx]; }
    }
#undef RW_XFORM
#undef RW_LOAD
#undef RW_RD
#undef RW_STEP
    if (tid < 256) {
#pragma unroll
        for (int rr = 0; rr < RPL; ++rr) *(GAS f32x4*)(st_out + (size_t)(rbase + il + 16 * rr) * 64 + 4 * jp) = (f32x4){S01[rr].x, S01[rr].y, S23[rr].x, S23[rr].y};
    }
    LBAR();
}

template <int CPL>
__device__ __forceinline__ void ret_unit(LAS float* L, const bf16* Z, const f32x2* ROT, int s, int h, int vs, const float* st_in, float* st_out, float* ORAW, int tid) {
    constexpr int TB = CPL == 1 ? 16 : 8, NV = 16 * CPL, NVG = NV / 8, NG = TB * NVG, BUF = TB * (512 + NV), OPB = 8 * TB * NV;
    LAS float* Q = L; LAS float* K = Q + TB * 256; LAS float* V = K + TB * 256; LAS float* OP = L + 2 * BUF; LAS float* DUM = OP + 2 * OPB;
    const int T = seq_T(s), row0 = seq_row0(s), pbase = s < NPB ? 0 : 2048;
    const int w = tid >> 6, lane = tid & 63, vl = lane >> 2, dl = lane & 3, dk0 = 32 * w + 8 * dl;
    const int vcol0 = vs * NV + vl * CPL;
    const float lg2 = log2f(1.0f - exp2f(-5.0f - (float)h)), gTB = exp2f(lg2 * (float)TB);
    f32x2 S[CPL][4];
#pragma unroll
    for (int c = 0; c < CPL; ++c)
#pragma unroll
        for (int e = 0; e < 4; ++e) { S[c][e] = (f32x2){0.f, 0.f}; if (st_in) { S[c][e].x = st_in[(size_t)(dk0 + 2 * e) * 256 + vcol0 + c]; S[c][e].y = st_in[(size_t)(dk0 + 2 * e + 1) * 256 + vcol0 + c]; } }
    const int ptt = tid >> 4, pseg = tid & 15; const bool pact = ptt < TB;
    const int gtt = tid / NVG, gc8 = (tid % NVG) * 8; const bool gact = tid < NG;
    const float qs = exp2f(lg2 * (float)(ptt + 1)), ks = 0.0625f * exp2f(-lg2 * (float)(ptt + 1));
    v4u rq0 = (v4u){0u, 0u, 0u, 0u}, rq1 = rq0, rk0 = rq0, rk1 = rq0, rv = rq0; f32x4 rt[4];
#pragma unroll
    for (int i = 0; i < 4; ++i) rt[i] = (f32x4){0.f, 0.f, 0.f, 0.f};
#define RT_LOAD(t0_) do { if (pact) { const bf16* zr_ = Z + (size_t)(row0 + (t0_) + ptt) * DINO + h * 256 + 16 * pseg; rq0 = *(const GAS v4u*)zr_; rq1 = *(const GAS v4u*)(zr_ + 8); rk0 = *(const GAS v4u*)(zr_ + 1024); rk1 = *(const GAS v4u*)(zr_ + 1032); \
            const GAS f32x4* tp_ = (const GAS f32x4*)(ROT + (size_t)(pbase + (t0_) + ptt) * 128 + 8 * pseg); rt[0] = tp_[0]; rt[1] = tp_[1]; rt[2] = tp_[2]; rt[3] = tp_[3]; } \
        if (gact) rv = *(const GAS v4u*)(Z + (size_t)(row0 + (t0_) + gtt) * DINO + 2048 + h * 256 + vs * NV + gc8); } while (0)
#define RT_RD(qa_, qb_, ka_, kb_, v_, tt_) do { qa_ = *(const LAS f32x4*)(Q + bo + (tt_) * 256 + dk0); qb_ = *(const LAS f32x4*)(Q + bo + (tt_) * 256 + dk0 + 4); ka_ = *(const LAS f32x4*)(K + bo + (tt_) * 256 + dk0); kb_ = *(const LAS f32x4*)(K + bo + (tt_) * 256 + dk0 + 4); \
        if constexpr (CPL == 1) v_[0] = vreg[(tt_)]; else lds_vec<CPL>(V + bo + (tt_) * NV + vl * CPL, v_); __builtin_amdgcn_sched_barrier(0); } while (0)
#define RT_STEP(qa_, qb_, ka_, kb_, v_, tt_) do { _Pragma("unroll") for (int c = 0; c < CPL; ++c) { const f32x2 vb_ = (f32x2){v_[c], v_[c]}; \
            S[c][0] += (f32x2){ka_.x, ka_.y} * vb_; S[c][1] += (f32x2){ka_.z, ka_.w} * vb_; S[c][2] += (f32x2){kb_.x, kb_.y} * vb_; S[c][3] += (f32x2){kb_.z, kb_.w} * vb_; \
            const f32x2 t_ = (S[c][0] * (f32x2){qa_.x, qa_.y} + S[c][1] * (f32x2){qa_.z, qa_.w}) + (S[c][2] * (f32x2){qb_.x, qb_.y} + S[c][3] * (f32x2){qb_.z, qb_.w}); \
            const float o_ = quad_sum(t_.x + t_.y); if constexpr (CPL == 1) { okeep[(tt_) & 3] = (dl == ((tt_) >> 2)) ? o_ : okeep[(tt_) & 3]; } else opw[(tt_) * NV + c] = o_; } } while (0)
#define RT_XFORM(bo_) do { if (pact) { \
            float q[16], k[16]; { float t8[8]; unpack8(rq0, t8); \
                _Pragma("unroll") for (int e = 0; e < 8; ++e) q[e] = t8[e] * qs; \
                unpack8(rq1, t8); \
                _Pragma("unroll") for (int e = 0; e < 8; ++e) q[8 + e] = t8[e] * qs; \
                unpack8(rk0, t8); \
                _Pragma("unroll") for (int e = 0; e < 8; ++e) k[e] = t8[e] * ks; \
                unpack8(rk1, t8); \
                _Pragma("unroll") for (int e = 0; e < 8; ++e) k[8 + e] = t8[e] * ks; } \
            float qo[16], ko[16]; \
            _Pragma("unroll") for (int p = 0; p < 8; ++p) { const float sn = (p & 1) ? rt[p >> 1].z : rt[p >> 1].x, cs = (p & 1) ? rt[p >> 1].w : rt[p >> 1].y; \
                qo[2 * p] = q[2 * p] * cs - q[2 * p + 1] * sn; qo[2 * p + 1] = q[2 * p + 1] * cs + q[2 * p] * sn; \
                ko[2 * p] = k[2 * p] * cs - k[2 * p + 1] * sn; ko[2 * p + 1] = k[2 * p + 1] * cs + k[2 * p] * sn; } \
            LAS f32x4* qd = (LAS f32x4*)(Q + (bo_) + ptt * 256 + 16 * pseg); LAS f32x4* kd = (LAS f32x4*)(K + (bo_) + ptt * 256 + 16 * pseg); \
            _Pragma("unroll") for (int i = 0; i < 4; ++i) { qd[i] = (f32x4){qo[4 * i], qo[4 * i + 1], qo[4 * i + 2], qo[4 * i + 3]}; kd[i] = (f32x4){ko[4 * i], ko[4 * i + 1], ko[4 * i + 2], ko[4 * i + 3]}; } } \
        if (gact) { float v8[8]; unpack8(rv, v8); \
            if constexpr (CPL == 1) { _Pragma("unroll") for (int e = 0; e < 8; ++e) V[(bo_) + (gc8 + e) * TB + gtt] = v8[e]; } \
            else { LAS f32x4* vd = (LAS f32x4*)(V + (bo_) + gtt * NV + gc8); vd[0] = (f32x4){v8[0], v8[1], v8[2], v8[3]}; vd[1] = (f32x4){v8[4], v8[5], v8[6], v8[7]}; } } } while (0)
    RT_LOAD(0);
    RT_XFORM(0);
    LBAR();
    for (int t0 = 0, pb = 0; t0 < T; t0 += TB, pb ^= 1) {
        const int bo = pb * BUF, oo = pb * OPB; const bool more = t0 + TB < T;
        LAS float* opw = (dl == 0) ? OP + oo + w * TB * NV + vl * CPL : DUM + lane;
        if (more) RT_LOAD(t0 + TB);
        {
            f32x4 qa0, qa1, ka0, ka1, qb0, qb1, kb0, kb1; float va[CPL], vb[CPL]; float vreg[16]; f32x4 okeep = (f32x4){0.f, 0.f, 0.f, 0.f};
            if constexpr (CPL == 1) lds_vec<16>(V + bo + vl * TB, vreg);
            RT_RD(qa0, qa1, ka0, ka1, va, 0);
#pragma unroll
            for (int tt = 0; tt < TB; tt += 2) {
                RT_RD(qb0, qb1, kb0, kb1, vb, tt + 1);
                RT_STEP(qa0, qa1, ka0, ka1, va, tt);
                if (tt + 2 < TB) RT_RD(qa0, qa1, ka0, ka1, va, tt + 2);
                RT_STEP(qb0, qb1, kb0, kb1, vb, tt + 1);
            }
            if constexpr (CPL == 1) *(LAS f32x4*)(OP + oo + (w * 16 + vl) * TB + 4 * dl) = okeep;
        }
#pragma unroll
        for (int c = 0; c < CPL; ++c)
#pragma unroll
            for (int e = 0; e < 4; ++e) S[c][e] = S[c][e] * gTB;
        if (more) RT_XFORM((pb ^ 1) * BUF);
        LBAR();
        for (int idx = tid; idx < TB * NV; idx += NTHR) { const int tt = idx / NV, c = idx - tt * NV; float o = 0.f;
#pragma unroll
            for (int ww = 0; ww < 8; ++ww) o += (CPL == 1) ? OP[oo + (ww * 16 + c) * TB + tt] : OP[oo + (ww * TB + tt) * NV + c];
            ORAW[(size_t)(row0 + t0 + tt) * 1024 + h * 256 + vs * NV + c] = o; }
    }
#undef RT_XFORM
#undef RT_LOAD
#undef RT_RD
#undef RT_STEP
#pragma unroll
    for (int c = 0; c < CPL; ++c)
#pragma unroll
        for (int e = 0; e < 4; ++e) { st_out[(size_t)(dk0 + 2 * e) * 256 + vcol0 + c] = S[c][e].x; st_out[(size_t)(dk0 + 2 * e + 1) * 256 + vcol0 + c] = S[c][e].y; }
    LBAR();
}

struct LruP { const float *cw, *cb, *lam; };
template <bool WRITE>
__device__ __forceinline__ f32x2 rglru_seg(const bf16* Z, const float* SG, bf16* O, const LruP P, int s, int ch, int tb, int n, float h0, const float* st_conv) {
    const int row0 = seq_row0(s); const bool prompt = s < NPB;
    const float lam_sp = log1pf(__expf(-P.lam[ch]));
    const float cw0 = P.cw[ch], cw1 = P.cw[1024 + ch], cw2 = P.cw[2048 + ch], cw3 = P.cw[3072 + ch], cb = P.cb[ch];
    float x3, x2, x1;
    {
        float tap[3];
#pragma unroll
        for (int m = 0; m < 3; ++m) { const int tm = tb - 3 + m;
            tap[m] = tm >= 0 ? bf2f(Z[(size_t)(row0 + tm) * DINO + 5120 + ch]) : (st_conv ? st_conv[(size_t)(3 + tm) * 1024 + ch] : 0.f); }
        x3 = tap[0]; x2 = tap[1]; x1 = tap[2];
    }
    float hh = h0, A = 1.0f;
    for (int t8 = tb; t8 < tb + n; t8 += 8) {
        float xs[8], pa[8], px[8], yb[8];
#pragma unroll
        for (int u = 0; u < 8; ++u) { const size_t row = (size_t)(row0 + t8 + u); xs[u] = bf2f(Z[row * DINO + 5120 + ch]); pa[u] = SG[row * 2048 + ch]; px[u] = SG[row * 2048 + 1024 + ch]; yb[u] = WRITE ? bf2f(Z[row * DINO + 4096 + ch]) : 0.f; }
#pragma unroll
        for (int u = 0; u < 8; ++u) {
            const float x0 = xs[u];
            const float xc = cb + ((cw0 * x3 + cw1 * x2) + (cw2 * x1 + cw3 * x0));
            const float rg = sigm(pa[u]), ig = sigm(px[u]);
            const float a = __expf(-8.0f * rg * lam_sp);
            const float mult = (prompt && (t8 + u) == 0) ? 1.0f : sqrtf(fmaxf(1.0f - a * a, 0.f));
            hh = a * hh + mult * ig * xc; A *= a;
            if (WRITE) { const float y = yb[u]; const float uu = 0.7978845608f * (y + 0.044715f * y * y * y);
                O[(size_t)(row0 + t8 + u) * 2048 + 1024 + ch] = (bf16)f2bf(hh * y * sigm(2.0f * uu)); }
            x3 = x2; x2 = x1; x1 = x0;
        }
    }
    return (f32x2){A, hh};
}

#define CAS __attribute__((address_space(4)))
struct Args { const float* in[38]; float* out; unsigned char* ws; int ph_lo, ph_hi; };
__device__ __forceinline__ int opaque_tid() { int t = threadIdx.x; asm volatile("" : "+v"(t)); return t; }
__device__ __forceinline__ const CAS Args* opaque_args() { size_t z = 0; asm volatile("" : "+s"(z)); return (const CAS Args*)((const CAS char*)__builtin_amdgcn_kernarg_segment_ptr() + z); }
#ifndef MK_ONE_LAUNCH
#define MK_ONE_LAUNCH 1
#endif
#ifndef DIS_P0
#define DIS_P0 0
#endif
#ifndef DIS_A
#define DIS_A 0
#endif
#ifndef DIS_B
#define DIS_B 0
#endif
#ifndef DIS_C
#define DIS_C 0
#endif
#ifndef DIS_D
#define DIS_D 0
#endif
#ifndef DIS_E
#define DIS_E 0
#endif
#ifndef DIS_A2
#define DIS_A2 0
#endif
#ifndef DIS_F
#define DIS_F 0
#endif
#ifndef DIS_G
#define DIS_G 0
#endif
#ifndef REP_P0
#define REP_P0 1
#endif
#ifndef REP_A
#define REP_A 1
#endif
#ifndef REP_B
#define REP_B 1
#endif
#ifndef REP_C
#define REP_C 1
#endif
#ifndef REP_D
#define REP_D 1
#endif
#ifndef REP_E
#define REP_E 1
#endif
#ifndef REP_A2
#define REP_A2 1
#endif
#ifndef REP_F
#define REP_F 1
#endif
#ifndef REP_G
#define REP_G 1
#endif
#ifndef REP_BE_P
#define REP_BE_P 1
#endif
#ifndef REP_BE_D
#define REP_BE_D 1
#endif
#ifndef REP_BO_P
#define REP_BO_P 1
#endif
#ifndef REP_BO_D
#define REP_BO_D 1
#endif
#ifndef REP_DE_P
#define REP_DE_P 1
#endif
#ifndef REP_DE_D
#define REP_DE_D 1
#endif
constexpr int N_PHASES = 39;

__global__ void __launch_bounds__(NTHR, 2) mega_fwd(Args args) {
    extern __shared__ __attribute__((aligned(16))) unsigned char lds_raw[];
    LAS unsigned char* lds = (LAS unsigned char*)lds_raw;
    volatile LAS unsigned* MISC = (volatile LAS unsigned*)(lds + MISC_OFF);
    const int G = gridDim.x, bx = blockIdx.x;
    for (int u = threadIdx.x; u < (LDS_BYTES - LDSCTL_OFF) / 4; u += NTHR) ((LAS unsigned*)(lds + LDSCTL_OFF))[u] = 0u;
    __syncthreads();
#if MK_ONE_LAUNCH
    XcdBarrier bar = xcd_barrier_post((unsigned*)(args.ws + WS_CTL) + CW_BAR, MISC + 8);
#define GRID_BAR() xcd_barrier(bar)
#else
#define GRID_BAR() do { } while (0)
#endif
    const int lo = args.ph_lo, hi = args.ph_hi;
    int ph = 0;
#define IN_PH (lo <= ph && ph < hi)
#define END_PH do { if (IN_PH && (ph + 1) < hi) GRID_BAR(); ++ph; } while (0)

#define PHASE_ENV \
    const int tid = opaque_tid(); const int lane = tid & 63, wave = __builtin_amdgcn_readfirstlane(tid >> 6); \
    const int gw = bx * NWAVES + wave, NGW = G * NWAVES, gt = bx * NTHR + tid, NGT = G * NTHR; (void)gw; (void)NGW; (void)gt; (void)NGT; (void)lane; \
    const CAS Args* ap = opaque_args(); unsigned char* ws = ap->ws; float* out = ap->out; (void)out; \
    bf16* HN = (bf16*)(ws + WS_HN); bf16* Z = (bf16*)(ws + WS_Z); bf16* OB = (bf16*)(ws + WS_O); float* MIX = (float*)(ws + WS_MIX); bf16* ACT = (bf16*)(ws + WS_ACT); \
    bf16* SA = (bf16*)(ws + WS_SA); float* SG = (float*)(ws + WS_SG); float* ORAW = (float*)(ws + WS_ORAW); float* YRAW = (float*)(ws + WS_YRAW); float* RKB = (float*)(ws + WS_RK); \
    const f32x2* ROT = (const f32x2*)(ws + WS_ROT); (void)HN; (void)Z; (void)OB; (void)MIX; (void)ACT; (void)SA; (void)SG; (void)ORAW; (void)YRAW; (void)RKB; (void)ROT;
#define AIN(k) (ap->in[k])

    if (IN_PH && !DIS_P0) for (int rep_ = 0; rep_ < REP_P0; ++rep_) { PHASE_ENV
        LAS unsigned char* scr = lds + RING_OFF + wave * 9216;
        constexpr int I_IE = (DM / 64) * (DINE / 64), I_OE = (DM / 64) * (DM / 64), I_IO = (DM / 64) * (DINO / 64), I_FI = (DM / 64) * (2 * DFF / 64), I_FO = (DFF / 64) * (DM / 64);
        constexpr int NITEMS = 2 * I_IE + 2 * I_OE + 2 * I_IO + 2 * I_OE + 4 * I_FI + 4 * I_FO;
        for (int it = gw; it < NITEMS; it += NGW) {
            int r = it;
            if (r < 2 * I_IE) { const int l = r / I_IE; p0_transpose_item(AIN(12) + (size_t)l * DM * DINE, DM, DINE, (bf16*)(ws + WS_WIE) + (size_t)l * DINE * DM, 0, scr, r - l * I_IE, lane); continue; } r -= 2 * I_IE;
            if (r < 2 * I_OE) { const int l = r / I_OE; p0_transpose_item(AIN(13) + (size_t)l * DM * DM, DM, DM, (bf16*)(ws + WS_WOE) + (size_t)l * DM * DM, 0, scr, r - l * I_OE, lane); continue; } r -= 2 * I_OE;
            if (r < 2 * I_IO) { const int l = r / I_IO; p0_transpose_item(AIN(27) + (size_t)l * DM * DINO, DM, DINO, (bf16*)(ws + WS_WIO) + (size_t)l * DINO * DM, 0, scr, r - l * I_IO, lane); continue; } r -= 2 * I_IO;
            if (r < 2 * I_OE) { const int l = r / I_OE; p0_transpose_item(AIN(28) + (size_t)l * DM * DM, DM, DM, (bf16*)(ws + WS_WOO) + (size_t)l * DM * DM, 0, scr, r - l * I_OE, lane); continue; } r -= 2 * I_OE;
            if (r < 4 * I_FI) { const int l = r / I_FI; p0_transpose_item(AIN(36) + (size_t)l * DM * 2 * DFF, DM, 2 * DFF, (bf16*)(ws + WS_WFI) + (size_t)l * 2 * DFF * DM, 1, scr, r - l * I_FI, lane); continue; } r -= 4 * I_FI;
            { const int l = r / I_FO; p0_transpose_item(AIN(37) + (size_t)l * DFF * DM, DFF, DM, (bf16*)(ws + WS_WFO) + (size_t)l * DM * DFF, 0, scr, r - l * I_FO, lane); }
        }
        for (int idx = gt; idx < 2 * 3072 * 256; idx += NGT) { const int jj = idx / (3072 * 256), r = idx - jj * 3072 * 256, n = r >> 8, k = r & 255; float v = 0.f;
            if (n < 1024) { if (k < 64) v = AIN(18)[((size_t)jj * 64 + k) * 1024 + n]; }
            else if (n < 2048) { if (k >= 64 && k < 128) v = AIN(20)[((size_t)jj * 64 + (k - 64)) * 1024 + (n - 1024)]; }
            else { if (k >= 128) v = AIN(21)[((size_t)jj * 128 + (k - 128)) * 1024 + (n - 2048)]; }
            ((bf16*)(ws + WS_WLR))[idx] = (bf16)f2bf(v); }
        for (int idx = gt; idx < 2 * 3072; idx += NGT) { const int jj = idx / 3072, n = idx - jj * 3072;
            ((float*)(ws + WS_BLR))[idx] = n < 1024 ? AIN(17)[jj * 1024 + n] : (n < 2048 ? AIN(19)[jj * 1024 + n - 1024] : 0.f); }
        for (int idx = gt; idx < 2 * 2048 * 256; idx += NGT) { const int jj = idx / (2048 * 256), r = idx - jj * 2048 * 256, n = r >> 8, k = r & 255, n2 = n & 1023, hd = n2 >> 8, jc = n2 & 255;
            const float* src = n < 1024 ? AIN(31) : AIN(33);
            ((bf16*)(ws + WS_WGT))[idx] = (bf16)f2bf(src[(((size_t)jj * 4 + hd) * 256 + k) * 256 + jc]); }
        for (int idx = gt; idx < 2 * 2048; idx += NGT) { const int jj = idx / 2048, n = idx - jj * 2048;
            ((float*)(ws + WS_BGT))[idx] = n < 1024 ? AIN(32)[jj * 1024 + n] : AIN(34)[jj * 1024 + n - 1024]; }
        for (int idx = gt; idx < 2056 * 128; idx += NGT) { const int pi = idx >> 7, i = idx & 127; const double pos = pi < 2048 ? (double)pi : (double)(16384 + pi - 2048);
            const double ang = pos * exp(-9.210340371976184 * ((double)i / 127.0));
            ((f32x2*)(ws + WS_ROT))[idx] = (f32x2){(float)sin(ang), (float)cos(ang)}; }
        for (int row = gw; row < M; row += NGW) {
            const float* xin = row < MP ? AIN(0) + (size_t)row * DM : AIN(1) + (size_t)(row - MP) * DM;
            norm_row<false, true>(xin, nullptr, out + (size_t)row * DM, nullptr, AIN(8), HN + (size_t)row * DM, lane);
        }
    }
    END_PH;

    for (int hl = 0; hl < 8; ++hl) {
        const int l = hl >> 1, j = l >> 1; const bool mixer = (hl & 1) == 0, even = (l & 1) == 0;
        if (mixer) {
            if (IN_PH && !DIS_A) for (int rep_ = 0; rep_ < REP_A; ++rep_) { PHASE_ENV
                const int N = even ? DINE : DINO;
                const bf16* Bt = even ? (const bf16*)(ws + WS_WIE) + (size_t)j * DINE * DM : (const bf16*)(ws + WS_WIO) + (size_t)j * DINO * DM;
                pg8::Gemm g{HN, Bt, M, N, DM, DM, DM, 0}; pg8::StaticOrder S; S.init(M, N, G, bx, DM);
                pg8::EpiBf16<0> E{Z, N, nullptr, 0, 0, 1.f};
                pg8::gemm_phase<pg8::EpiBf16<0>, pg8::StaticOrder, true, true>(lds + RING_OFF, g, S, E);
            }
            END_PH;
            if (IN_PH && !DIS_B) for (int rep_ = 0; rep_ < REP_B; ++rep_) { PHASE_ENV
                LAS float* L = (LAS float*)(lds + RING_OFF);
                if (even) {
                    const float* mu = AIN(16) + (size_t)j * DRP; const float* st_shift = AIN(4) + (size_t)j * NDB * DRP;
                    for (int idx = gt; idx < M * 32; idx += NGT) {
                        const int row = idx >> 5, c8 = idx & 31; int t, s; row_ts(row, t, s);
                        const bf16* zr = Z + (size_t)row * DINE + 7168 + c8 * 8;
                        float c[8], p[8]; unpack8(*(const GAS v4u*)zr, c);
                        if (t > 0) unpack8(*(const GAS v4u*)(zr - DINE), p);
                        else {
#pragma unroll
                            for (int e = 0; e < 8; ++e) p[e] = s >= NPB ? st_shift[(size_t)(s - NPB) * DRP + 3072 + c8 * 8 + e] : 0.f; }
                        float o[8];
#pragma unroll
                        for (int e = 0; e < 8; ++e) { const float zs = c[e] + (p[e] - c[e]) * mu[3072 + c8 * 8 + e];
                            o[e] = c8 < 8 ? 2.0f * sigm(2.0f * zs) - 1.0f : (c8 < 16 ? zs : sigm(zs)); }
                        *(GAS v4u*)(SA + (size_t)row * 256 + c8 * 8) = pack8(o);
                    }
                    for (int idx = gt; idx < NSEQ * DRP; idx += NGT) { const int s = idx / DRP, c = idx - s * DRP;
                        st_out_ptr(out, O_SHIFT_P, O_SHIFT_S, DRP, j, s)[c] = bf2f(Z[(size_t)(seq_row0(s) + seq_T(s) - 1) * DINE + 4096 + c]); }
                    const float* lbraw = AIN(14);
                    for (int u = bx; u < 256 + 1024; u += G) {
                        if (u < 256) { const int s = u >> 6, h = (u >> 3) & 7, vs = u & 7;
                            for (int r2_ = 0; r2_ < REP_BE_P; ++r2_) hgrn_unit<1>(L, Z, j, s, h, vs, nullptr, st_out_ptr(out, O_HGRN_P, O_HGRN_S, SZ_HGRN, j, s) + (size_t)h * 16384, ORAW, lbraw, tid); }
                        else { const int u2 = u - 256, b = u2 >> 3, h = u2 & 7, s = NPB + b;
                            for (int r2_ = 0; r2_ < REP_BE_D; ++r2_) hgrn_unit<8>(L, Z, j, s, h, 0, AIN(2) + ((size_t)j * NDB + b) * SZ_HGRN + (size_t)h * 16384, st_out_ptr(out, O_HGRN_P, O_HGRN_S, SZ_HGRN, j, s) + (size_t)h * 16384, ORAW, lbraw, tid); }
                    }
                } else {
                    const float* cw = AIN(29) + (size_t)j * 4 * 1024; const float* cb = AIN(30) + (size_t)j * 1024; const float* st_conv = AIN(6) + (size_t)j * NDB * SZ_CONV;
                    for (int idx = gt; idx < M * 128; idx += NGT) {
                        const int row = idx >> 7, c8 = idx & 127, c0 = c8 * 8; int t, s; row_ts(row, t, s);
                        float acc[8];
#pragma unroll
                        for (int e = 0; e < 8; ++e) acc[e] = cb[c0 + e];
#pragma unroll
                        for (int m = 0; m < 4; ++m) { const int tm = t - 3 + m; float x[8];
                            if (tm >= 0) unpack8(*(const GAS v4u*)(Z + (size_t)(row - 3 + m) * DINO + 5120 + c0), x);
                            else {
#pragma unroll
                                for (int e = 0; e < 8; ++e) x[e] = s >= NPB ? st_conv[(size_t)(s - NPB) * SZ_CONV + (size_t)(3 + tm) * 1024 + c0 + e] : 0.f; }
#pragma unroll
                            for (int e = 0; e < 8; ++e) acc[e] += cw[m * 1024 + c0 + e] * x[e]; }
                        *(GAS v4u*)(SA + (size_t)row * 1024 + c0) = pack8(acc);
                    }
                    for (int idx = gt; idx < NSEQ * 3 * 1024; idx += NGT) { const int s = idx / 3072, r = (idx - s * 3072) >> 10, c = idx & 1023;
                        st_out_ptr(out, O_CONV_P, O_CONV_S, SZ_CONV, j, s)[r * 1024 + c] = bf2f(Z[(size_t)(seq_row0(s) + seq_T(s) - 3 + r) * DINO + 5120 + c]); }
                    for (int u = bx; u < 256 + 2048; u += G) {
                        if (u < 256) { const int s = u >> 6, h = (u >> 4) & 3, vs = u & 15;
                            for (int r2_ = 0; r2_ < REP_BO_P; ++r2_) ret_unit<1>(L, Z, ROT, s, h, vs, nullptr, st_out_ptr(out, O_RET_P, O_RET_S, SZ_RET, j, s) + (size_t)h * 65536, ORAW, tid); }
                        else { const int u2 = u - 256, b = u2 >> 4, h = (u2 >> 2) & 3, vs = u2 & 3, s = NPB + b;
                            for (int r2_ = 0; r2_ < REP_BO_D; ++r2_) ret_unit<4>(L, Z, ROT, s, h, vs, AIN(5) + ((size_t)j * NDB + b) * SZ_RET + (size_t)h * 65536, st_out_ptr(out, O_RET_P, O_RET_S, SZ_RET, j, s) + (size_t)h * 65536, ORAW, tid); }
                    }
                }
            }
            END_PH;
            if (IN_PH && !DIS_C) for (int rep_ = 0; rep_ < REP_C; ++rep_) { PHASE_ENV
                const int N = even ? 3072 : 2048;
                const bf16* Bt = even ? (const bf16*)(ws + WS_WLR) + (size_t)j * 3072 * 256 : (const bf16*)(ws + WS_WGT) + (size_t)j * 2048 * 256;
                const float* bias = even ? (const float*)(ws + WS_BLR) + j * 3072 : (const float*)(ws + WS_BGT) + j * 2048;
                pg8::Gemm g{SA, Bt, M, N, 256, even ? 256 : 1024, 256, even ? 0 : 3}; pg8::StaticOrder S; S.init(M, N, G, bx, 256);
                pg8::EpiF32 E{SG, N, bias, nullptr, 0, 0};
                pg8::gemm_phase<pg8::EpiF32, pg8::StaticOrder, true, true>(lds + RING_OFF, g, S, E);
            }
            END_PH;
            if (IN_PH && !DIS_D) for (int rep_ = 0; rep_ < REP_D; ++rep_) { PHASE_ENV
                LAS float* L = (LAS float*)(lds + RING_OFF);
                if (even) {
                    const RwkvP P{AIN(16) + (size_t)j * DRP, AIN(22) + (size_t)j * 1024, AIN(23) + (size_t)j * 1024, AIN(24) + (size_t)j * 1024};
                    for (int u = bx; u < 256 + 2048; u += G) {
                        if (u < 256) { const int s = u >> 6, h = (u >> 2) & 15, sl = u & 3;
                            for (int r2_ = 0; r2_ < REP_DE_P; ++r2_) rwkv_unit<1>(L, Z, SG, P, s, h, sl * 16, sl == 0, nullptr, nullptr, st_out_ptr(out, O_RWKV_P, O_RWKV_S, SZ_RWKV, j, s) + (size_t)h * 4096, YRAW, RKB, tid); }
                        else { const int u2 = u - 256, b = u2 >> 4, h = u2 & 15, s = NPB + b;
                            for (int r2_ = 0; r2_ < REP_DE_D; ++r2_) rwkv_unit<4>(L, Z, SG, P, s, h, 0, true, AIN(4) + ((size_t)j * NDB + b) * DRP, AIN(3) + ((size_t)j * NDB + b) * SZ_RWKV + (size_t)h * 4096,
                                         st_out_ptr(out, O_RWKV_P, O_RWKV_S, SZ_RWKV, j, s) + (size_t)h * 4096, YRAW, RKB, tid); }
                    }
                } else {
                    for (int row = gw; row < M; row += NGW) {
                        const GAS f32x4* orow = (const GAS f32x4*)(ORAW + (size_t)row * 1024 + 16 * lane);
                        float o[16];
#pragma unroll
                        for (int q = 0; q < 4; ++q) { const f32x4 v = orow[q]; o[4 * q] = v.x; o[4 * q + 1] = v.y; o[4 * q + 2] = v.z; o[4 * q + 3] = v.w; }
                        float ss = 0.f;
#pragma unroll
                        for (int e = 0; e < 16; ++e) ss += o[e] * o[e];
                        const float rs = rsqrtf(row16_sum(ss) * (1.0f / 256.0f) + RMS_EPS);
                        float g[16]; { float t8[8]; unpack8(*(const GAS v4u*)(Z + (size_t)row * DINO + 3072 + 16 * lane), t8);
#pragma unroll
                            for (int e = 0; e < 8; ++e) g[e] = t8[e];
                            unpack8(*(const GAS v4u*)(Z + (size_t)row * DINO + 3072 + 16 * lane + 8), t8);
#pragma unroll
                            for (int e = 0; e < 8; ++e) g[8 + e] = t8[e]; }
                        float r0[8], r1[8];
#pragma unroll
                        for (int e = 0; e < 8; ++e) { r0[e] = o[e] * rs * siluf(g[e]); r1[e] = o[8 + e] * rs * siluf(g[8 + e]); }
                        *(GAS v4u*)(OB + (size_t)row * DM + 16 * lane) = pack8(r0); *(GAS v4u*)(OB + (size_t)row * DM + 16 * lane + 8) = pack8(r1);
                    }
                    const LruP P{AIN(29) + (size_t)j * 4 * 1024, AIN(30) + (size_t)j * 1024, AIN(35) + (size_t)j * 1024};
                    for (int u = bx; u < 256; u += G) {
                        const int s = u >> 6, cg = u & 63, cl = tid & 15, ch = cg * 16 + cl, chunk = tid >> 4;
                        __syncthreads();
                        const f32x2 ah = rglru_seg<false>(Z, SG, OB, P, s, ch, chunk * 64, 64, 0.f, nullptr);
                        L[chunk * 16 + cl] = ah.x; L[512 + chunk * 16 + cl] = ah.y;
                        __syncthreads();
                        float hin = 0.f;
                        for (int c2 = 0; c2 < chunk; ++c2) hin = L[c2 * 16 + cl] * hin + L[512 + c2 * 16 + cl];
                        const f32x2 r = rglru_seg<true>(Z, SG, OB, P, s, ch, chunk * 64, 64, hin, nullptr);
                        if (chunk == 31) st_out_ptr(out, O_H_P, O_H_S, 1024, j, s)[ch] = r.y;
                    }
                    for (int idx = gt; idx < NDB * 1024; idx += NGT) { const int b = idx >> 10, ch = idx & 1023, s = NPB + b;
                        const f32x2 r = rglru_seg<true>(Z, SG, OB, P, s, ch, 0, DSEQ, AIN(7)[((size_t)j * NDB + b) * 1024 + ch], AIN(6) + ((size_t)j * NDB + b) * SZ_CONV);
                        st_out_ptr(out, O_H_P, O_H_S, 1024, j, s)[ch] = r.y; }
                }
            }
            END_PH;
            if (even) {
                if (IN_PH && !DIS_E) for (int rep_ = 0; rep_ < REP_E; ++rep_) { PHASE_ENV
                    const float* nw = AIN(15) + (size_t)j * 1024; const float* lnw = AIN(25) + (size_t)j * 1024; const float* lnb = AIN(26) + (size_t)j * 1024;
                    const float* mu = AIN(16) + (size_t)j * DRP + 2048; const float* st_shift = AIN(4) + (size_t)j * NDB * DRP;
                    for (int row = gw; row < M; row += NGW) {
                        int t, s; row_ts(row, t, s);
                        const int c0 = 16 * lane;
                        {
                            const GAS f32x4* orow = (const GAS f32x4*)(ORAW + (size_t)row * 1024 + c0);
                            float o[16];
#pragma unroll
                            for (int q = 0; q < 4; ++q) { const f32x4 v = orow[q]; o[4 * q] = v.x; o[4 * q + 1] = v.y; o[4 * q + 2] = v.z; o[4 * q + 3] = v.w; }
                            float ss = 0.f;
#pragma unroll
                            for (int e = 0; e < 16; ++e) ss += o[e] * o[e];
                            const float rs = rsqrtf(oct_sum(ss) * (1.0f / 128.0f) + RMS_EPS);
                            float g0[8], g1[8]; unpack8(*(const GAS v4u*)(Z + (size_t)row * DINE + 3072 + c0), g0); unpack8(*(const GAS v4u*)(Z + (size_t)row * DINE + 3072 + c0 + 8), g1);
                            float r0[8], r1[8];
#pragma unroll
                            for (int e = 0; e < 8; ++e) { r0[e] = o[e] * rs * nw[c0 + e] * siluf(g0[e]); r1[e] = o[8 + e] * rs * nw[c0 + 8 + e] * siluf(g1[e]); }
                            *(GAS v4u*)(OB + (size_t)row * DM + c0) = pack8(r0); *(GAS v4u*)(OB + (size_t)row * DM + c0 + 8) = pack8(r1);
                        }
                        {
                            const GAS f32x4* yrow = (const GAS f32x4*)(YRAW + (size_t)row * 1024 + c0);
                            float y[16];
#pragma unroll
                            for (int q = 0; q < 4; ++q) { const f32x4 v = yrow[q]; y[4 * q] = v.x; y[4 * q + 1] = v.y; y[4 * q + 2] = v.z; y[4 * q + 3] = v.w; }
                            float sm = 0.f;
#pragma unroll
                            for (int e = 0; e < 16; ++e) sm += y[e];
                            const float mean = quad_sum(sm) * (1.0f / 64.0f); float sv = 0.f;
#pragma unroll
                            for (int e = 0; e < 16; ++e) { const float d = y[e] - mean; sv += d * d; }
                            const float rstd = rsqrtf(quad_sum(sv) * (1.0f / 64.0f) + GN_EPS);
                            const bf16* zv = Z + (size_t)row * DINE + 4096 + 2048 + c0;
                            float v0[8], v1[8], p0[8], p1[8]; unpack8(*(const GAS v4u*)zv, v0); unpack8(*(const GAS v4u*)(zv + 8), v1);
                            if (t > 0) { unpack8(*(const GAS v4u*)(zv - DINE), p0); unpack8(*(const GAS v4u*)(zv - DINE + 8), p1); }
                            else {
#pragma unroll
                                for (int e = 0; e < 8; ++e) { p0[e] = s >= NPB ? st_shift[(size_t)(s - NPB) * DRP + 2048 + c0 + e] : 0.f; p1[e] = s >= NPB ? st_shift[(size_t)(s - NPB) * DRP + 2048 + c0 + 8 + e] : 0.f; } }
                            const float rk = RKB[(size_t)row * 16 + (lane >> 2)];
                            const GAS f32x4* grow = (const GAS f32x4*)(SG + (size_t)row * 3072 + 2048 + c0);
                            float gt_[16];
#pragma unroll
                            for (int q = 0; q < 4; ++q) { const f32x4 v = grow[q]; gt_[4 * q] = v.x; gt_[4 * q + 1] = v.y; gt_[4 * q + 2] = v.z; gt_[4 * q + 3] = v.w; }
                            float r0[8], r1[8];
#pragma unroll
                            for (int e = 0; e < 8; ++e) {
                                const float va = v0[e] + (p0[e] - v0[e]) * mu[c0 + e], vb = v1[e] + (p1[e] - v1[e]) * mu[c0 + 8 + e];
                                r0[e] = ((y[e] - mean) * rstd * lnw[c0 + e] + lnb[c0 + e] + rk * va) * gt_[e];
                                r1[e] = ((y[8 + e] - mean) * rstd * lnw[c0 + 8 + e] + lnb[c0 + 8 + e] + rk * vb) * gt_[8 + e]; }
                            *(GAS v4u*)(OB + (size_t)row * DM + 1024 + c0) = pack8(r0); *(GAS v4u*)(OB + (size_t)row * DM + 1024 + c0 + 8) = pack8(r1);
                        }
                    }
                }
                END_PH;
            }
        } else {
            if (IN_PH && !DIS_A2) for (int rep_ = 0; rep_ < REP_A2; ++rep_) { PHASE_ENV
                pg8::Gemm g{HN, (const bf16*)(ws + WS_WFI) + (size_t)l * 2 * DFF * DM, M, 2 * DFF, DM, DM, DM, 0}; pg8::StaticOrder S; S.init(M, 2 * DFF, G, bx, DM);
                pg8::EpiSwiGLU E{ACT, DFF};
                pg8::gemm_phase<pg8::EpiSwiGLU, pg8::StaticOrder, true, true>(lds + RING_OFF, g, S, E);
            }
            END_PH;
        }
        if (IN_PH && !DIS_F) for (int rep_ = 0; rep_ < REP_F; ++rep_) { PHASE_ENV
            const bf16* A = mixer ? OB : ACT; const int K = mixer ? DM : DFF;
            const bf16* Bt = mixer ? (even ? (const bf16*)(ws + WS_WOE) : (const bf16*)(ws + WS_WOO)) + (size_t)j * DM * DM : (const bf16*)(ws + WS_WFO) + (size_t)l * DM * DFF;
            pg8::Gemm g{A, Bt, M, DM, K, K, K, 0}; pg8::FOrder S; S.init(M, DM, G, bx, K);
            pg8::EpiF32 E{MIX, DM, nullptr, (float*)(ws + WS_PART), (size_t)MS * DM, MP};
            pg8::gemm_phase<pg8::EpiF32, pg8::FOrder, true, true>(lds + RING_OFF, g, S, E);
        }
        END_PH;
        if (IN_PH && !DIS_G) for (int rep_ = 0; rep_ < REP_G; ++rep_) { PHASE_ENV
            const float* wpost = (mixer ? AIN(9) : AIN(11)) + (size_t)l * DM;
            const float* wpre = mixer ? AIN(10) + (size_t)l * DM : AIN(8) + (size_t)(l + 1 < 4 ? l + 1 : 0) * DM;
            const bool split = (G == 256); const float* PART = (const float*)(ws + WS_PART);
            for (int row = gw; row < M; row += NGW) {
                const bool sp = split && row >= MP; const float* mixr = sp ? PART + (size_t)(row - MP) * DM : MIX + (size_t)row * DM; const int np = sp ? 8 : 1;
                if (hl < 7) norm_row<true, true>(out + (size_t)row * DM, mixr, out + (size_t)row * DM, wpost, wpre, HN + (size_t)row * DM, lane, np, (size_t)MS * DM);
                else norm_row<true, false>(out + (size_t)row * DM, mixr, out + (size_t)row * DM, wpost, wpre, HN + (size_t)row * DM, lane, np, (size_t)MS * DM);
            }
        }
        END_PH;
    }
}

extern "C" void kernel_launch(void* const* d_in, const int* in_sizes, int n_in, void* d_out, int out_size, void* d_ws, size_t ws_size, hipStream_t stream) {
    static int grid = 0;
    if (grid == 0) {
        if (n_in != 38 || (size_t)out_size != O_END || ws_size < WS_END) { fprintf(stderr, "kernel_launch: unexpected sizes: n_in %d out %d ws %zu (need %zu)\n", n_in, out_size, ws_size, (size_t)WS_END); grid = -1; return; }
        int dev = 0, cus = 0, per_cu = 0;
        if (hipGetDevice(&dev) != hipSuccess || hipDeviceGetAttribute(&cus, hipDeviceAttributeMultiprocessorCount, dev) != hipSuccess) { grid = -1; return; }
        if (hipFuncSetAttribute((const void*)mega_fwd, hipFuncAttributeMaxDynamicSharedMemorySize, LDS_BYTES) != hipSuccess) { fprintf(stderr, "kernel_launch: hipFuncSetAttribute failed\n"); grid = -1; return; }
        if (hipOccupancyMaxActiveBlocksPerMultiprocessor(&per_cu, (const void*)mega_fwd, NTHR, LDS_BYTES) != hipSuccess || per_cu < 1) fprintf(stderr, "kernel_launch: occupancy query says %d\n", per_cu);
        (void)hipGetLastError();
        grid = cus;
    }
    if (grid < 0) return;
    (void)hipMemsetAsync((char*)d_ws + WS_CTL, 0, CTL_BYTES, stream);
    Args a{};
    for (int i = 0; i < 38; ++i) a.in[i] = (const float*)d_in[i];
    a.out = (float*)d_out; a.ws = (unsigned char*)d_ws;
#if MK_ONE_LAUNCH
    a.ph_lo = 0; a.ph_hi = N_PHASES;
    hipLaunchKernelGGL(mega_fwd, dim3(grid), dim3(NTHR), LDS_BYTES, stream, a);
#else
    for (int p = 0; p < N_PHASES; ++p) { a.ph_lo = p; a.ph_hi = p + 1; hipLaunchKernelGGL(mega_fwd, dim3(grid), dim3(NTHR), LDS_BYTES, stream, a); }
#endif
}
```
